# Optimizing an MI355X kernel written in HIP

```python
import jax
import jax.numpy as jnp
from jax import lax
import numpy as np

D_MODEL = 1024
BATCH = 4
SEQ = 4096
DEPTH = 4

GRID_W = 64
CTX_LEN = 256
N_BRANCH = 4
MIX_W = D_MODEL // N_BRANCH
HEAD_DIM = 64
N_HEADS = MIX_W // HEAD_DIM
MLSTM_CHUNK = 128
DECAY_LORA = 32
ICLR_LORA = 32
GATE_LORA = 64
RWKV_GN_EPS = 64e-5
Q_LORA = 192
KV_LORA = 128
QK_NOPE = 64
QK_ROPE = 32
V_HEAD = HEAD_DIM
ROPE_BASE = 10000.0
Q_BLOCK = 128
LRU_C = 8.0
CONV_W = 4
LRU_BLOCKS = N_HEADS
LRU_BS = MIX_W // LRU_BLOCKS
D_FF = 4 * D_MODEL
ALPHA = (2 * DEPTH) ** 0.25
BETA = (8 * DEPTH) ** -0.25
LN_EPS = 1e-5
RMS_EPS = 1e-6
MLSTM_COLS = 4 * MIX_W + 4 * N_HEADS
RWKV_COLS = 3 * MIX_W + 2 * DECAY_LORA + 2 * ICLR_LORA + GATE_LORA
MLA_COLS = Q_LORA + KV_LORA + QK_ROPE
LRU_COLS = MIX_W
IN_WIDTHS = (N_BRANCH * D_MODEL, MLSTM_COLS, RWKV_COLS, MLA_COLS, LRU_COLS)
D_IN = N_BRANCH * D_MODEL + MLSTM_COLS + RWKV_COLS + MLA_COLS + LRU_COLS

kernel_name = 'hybrid_flow_trunk_mlstm_rwkv7_mla_rglru'


def _split(u, widths):
    parts, start = [], 0
    for w in widths:
        parts.append(u[..., start:start + w])
        start += w
    return parts


def _maybe_flip(z, axis, rev):
    return jnp.flip(z, axis) if rev else z


def _layer_norm(x, g, b):
    xf = x.astype(jnp.float32)
    mu = jnp.mean(xf, -1, keepdims=True)
    var = jnp.mean(jnp.square(xf - mu), -1, keepdims=True)
    return ((xf - mu) * lax.rsqrt(var + LN_EPS) * g + b).astype(x.dtype)


def _head_norm(y, eps):
    mu = jnp.mean(y, -1, keepdims=True)
    var = jnp.mean(jnp.square(y - mu), -1, keepdims=True)
    return (y - mu) * lax.rsqrt(var + eps)


def _rms_norm(x, g):
    xf = x.astype(jnp.float32)
    return (xf * lax.rsqrt(jnp.mean(jnp.square(xf), -1, keepdims=True) + RMS_EPS) * g).astype(x.dtype)


def _modulate(x, shift, scale):
    return x * (1.0 + scale) + shift


def _axial_rope_tables(rows):
    quarter = QK_ROPE // 4
    inv = 1.0 / (ROPE_BASE ** (jnp.arange(quarter, dtype=jnp.float32) / quarter))
    row = jnp.repeat(jnp.arange(rows, dtype=jnp.float32), GRID_W)
    col = jnp.tile(jnp.arange(GRID_W, dtype=jnp.float32), rows)
    ang_r = row[:, None] * inv
    ang_c = col[:, None] * inv
    e = lambda z: z[None, :, None, :]
    return (e(jnp.cos(ang_r)), e(jnp.sin(ang_r)), e(jnp.cos(ang_c)), e(jnp.sin(ang_c)))


def _rotate(x, cos, sin):
    x1, x2 = jnp.split(x, 2, axis=-1)
    return jnp.concatenate([x1 * cos - x2 * sin, x2 * cos + x1 * sin], -1)


def _axial_rope(x, tabs):
    cos_r, sin_r, cos_c, sin_c = tabs
    xr, xc = jnp.split(x, 2, axis=-1)
    return jnp.concatenate([_rotate(xr, cos_r, sin_r), _rotate(xc, cos_c, sin_c)], -1).astype(x.dtype)


def _attend(q, k, v, scale):
    s = jnp.einsum('bqhd,bkhd->bhqk', q, k).astype(jnp.float32) * scale
    p = jax.nn.softmax(s, axis=-1).astype(v.dtype)
    return jnp.einsum('bhqk,bkhd->bqhd', p, v)


def _mlstm_chunkwise(q, k, v, li, lf, state):
    bsz, nh, t, dh = q.shape
    nc, cl = t // MLSTM_CHUNK, MLSTM_CHUNK
    q, k, v = [z.reshape(bsz, nh, nc, cl, dh) for z in (q, k, v)]
    li, lf = li.reshape(bsz, nh, nc, cl), lf.reshape(bsz, nh, nc, cl)
    bcum = jnp.cumsum(lf, axis=-1)
    g_tot = bcum[..., -1]
    a_end = g_tot[..., None] - bcum + li
    m_loc = jnp.max(a_end, axis=-1)
    w_end = jnp.exp(a_end - m_loc[..., None])
    c_loc = jnp.einsum('bhnlk,bhnlv->bhnkv', k * w_end[..., None], v)
    n_loc = jnp.einsum('bhnl,bhnlk->bhnk', w_end, k)

    def step(carry, inp):
        c0, n0, m0 = carry
        g_i, m_i, c_i, n_i = inp
        m1 = jnp.maximum(g_i + m0, m_i)
        s_old, s_new = jnp.exp(g_i + m0 - m1), jnp.exp(m_i - m1)
        c1 = s_old[..., None, None] * c0 + s_new[..., None, None] * c_i
        n1 = s_old[..., None] * n0 + s_new[..., None] * n_i
        return (c1, n1, m1), (c0, n0, m0)

    xs = tuple(jnp.moveaxis(z, 2, 0) for z in (g_tot, m_loc, c_loc, n_loc))
    final, prev = lax.scan(step, state, xs)
    c_prev, n_prev, m_prev = (jnp.moveaxis(z, 0, 2) for z in prev)
    lower = jnp.tril(jnp.ones((cl, cl), dtype=bool))
    log_d = jnp.where(lower, bcum[..., :, None] - bcum[..., None, :] + li[..., None, :], -jnp.inf)
    log_prev = bcum + m_prev[..., None]
    m_j = jnp.maximum(log_prev, jnp.max(log_d, axis=-1))
    qk = jnp.einsum('bhnjd,bhnsd->bhnjs', q, k) * jnp.exp(log_d - m_j[..., None])
    s_prev = jnp.exp(log_prev - m_j)
    num = (jnp.einsum('bhnjs,bhnsd->bhnjd', qk, v)
           + s_prev[..., None] * jnp.einsum('bhnjk,bhnkv->bhnjv', q, c_prev))
    den = jnp.sum(qk, -1) + s_prev * jnp.einsum('bhnjk,bhnk->bhnj', q, n_prev)
    h = num / jnp.maximum(jnp.abs(den), jnp.exp(-m_j))[..., None]
    return h.reshape(bsz, nh, t, dh), final


def _mlstm_mixer(u_ctx, u_lat, need_ctx, gate_b, norm_g):
    def prep(u):
        u = u.astype(jnp.float32)
        bsz, t = u.shape[:2]
        q, k, v, o, ifg = _split(u, (MIX_W, MIX_W, MIX_W, MIX_W, 4 * N_HEADS))
        hd = lambda z: z.reshape(bsz, t, N_HEADS, HEAD_DIM).transpose(0, 2, 1, 3)
        ifg = ifg.reshape(bsz, t, 2, 2, N_HEADS) + gate_b
        li = ifg[:, :, :, 0].transpose(0, 2, 3, 1)
        lf = jax.nn.log_sigmoid(ifg[:, :, :, 1]).transpose(0, 2, 3, 1)
        return hd(q), hd(k) * HEAD_DIM ** -0.5, hd(v), li, lf, o

    def finish(h, o):
        bsz, _, t, _ = h.shape
        h = _head_norm(h.transpose(0, 2, 1, 3), LN_EPS).reshape(bsz, t, MIX_W) * norm_g
        return h * jax.nn.sigmoid(o)

    qc, kc, vc, lic, lfc, oc = prep(u_ctx)
    ql, kl, vl, lil, lfl, ol = prep(u_lat)
    bsz = u_lat.shape[0]
    zero_state = (jnp.zeros((bsz, N_HEADS, HEAD_DIM, HEAD_DIM), jnp.float32),
                  jnp.zeros((bsz, N_HEADS, HEAD_DIM), jnp.float32),
                  jnp.zeros((bsz, N_HEADS), jnp.float32))
    h_c, h_l = [], []
    for d in range(2):
        f = lambda z, rev=(d == 1): _maybe_flip(z, 2, rev)
        hc, st = _mlstm_chunkwise(f(qc), f(kc), f(vc), f(lic[:, d]), f(lfc[:, d]), zero_state)
        hl, _ = _mlstm_chunkwise(f(ql), f(kl), f(vl), f(lil[:, d]), f(lfl[:, d]), st)
        h_c.append(f(hc))
        h_l.append(f(hl))
    out_lat = finish(h_l[0] + h_l[1], ol).astype(u_lat.dtype)
    out_ctx = finish(h_c[0] + h_c[1], oc).astype(u_ctx.dtype) if need_ctx else None
    return out_ctx, out_lat


def _rwkv7_scan(r, w, k, v, kk, a, s0):
    def step(s, inp):
        r_t, w_t, k_t, v_t, kk_t, a_t = inp
        sa = jnp.einsum('bhvk,bhk->bhv', s, kk_t)
        s = (s * w_t[:, :, None, :] - sa[..., None] * (kk_t * a_t)[:, :, None, :]
             + v_t[..., None] * k_t[:, :, None, :])
        return s, jnp.einsum('bhvk,bhk->bhv', s, r_t)

    xs = tuple(jnp.swapaxes(z, 0, 1) for z in (r, w, k, v, kk, a))
    s_fin, y = lax.scan(step, s0, xs)
    return jnp.swapaxes(y, 0, 1), s_fin


def _rwkv7_mixer(u_ctx, u_lat, need_ctx, mu, w0, w2, a0, a2, g2, k_k, k_a, r_k, gn_g):
    def prep(u):
        u = u.astype(jnp.float32)
        bsz, t = u.shape[:2]
        zero = jnp.zeros_like(u[:, :1])
        prev = jnp.concatenate([zero, u[:, :-1]], 1)
        nxt = jnp.concatenate([u[:, 1:], zero], 1)
        u = u + mu * (0.5 * (prev + nxt) - u)
        r, k, v, wd, ad, gd = _split(u, (MIX_W, MIX_W, MIX_W, 2 * DECAY_LORA, 2 * ICLR_LORA, GATE_LORA))
        wd = wd.reshape(bsz, t, 2, DECAY_LORA)
        ad = ad.reshape(bsz, t, 2, ICLR_LORA)
        w_log = -jax.nn.softplus(-(w0 + jnp.einsum('btdr,drc->btdc', jnp.tanh(wd), w2))) - 0.5
        decay = jnp.exp(-jnp.exp(w_log))
        a = jax.nn.sigmoid(a0 + jnp.einsum('btdr,drc->btdc', ad, a2))
        kk = (k * k_k).reshape(bsz, t, N_HEADS, HEAD_DIM)
        kk = kk * lax.rsqrt(jnp.maximum(jnp.sum(jnp.square(kk), -1, keepdims=True), 1e-12))
        kd = k[:, :, None, :] * (1.0 + (a - 1.0) * k_a)
        g = jax.nn.sigmoid(gd) @ g2
        return r, k, v, kk, decay, a, kd, g

    def run(p, d, s0):
        r, k, v, kk, decay, a, kd, g = p
        bsz, t = r.shape[:2]
        hd = lambda z: z.reshape(bsz, t, N_HEADS, HEAD_DIM)
        f = lambda z: _maybe_flip(z, 1, d == 1)
        y, s = _rwkv7_scan(f(hd(r)), f(hd(decay[:, :, d])), f(hd(kd[:, :, d])), f(hd(v)), f(kk),
                           f(hd(a[:, :, d])), s0)
        return f(y), s

    def finish(y, p):
        r, k, v, g = p[0], p[1], p[2], p[7]
        bsz, t = r.shape[:2]
        hd = lambda z: z.reshape(bsz, t, N_HEADS, HEAD_DIM)
        y = _head_norm(y, RWKV_GN_EPS) * gn_g.reshape(N_HEADS, HEAD_DIM)
        y = y + jnp.sum(hd(r) * hd(k) * r_k, -1, keepdims=True) * hd(v)
        return y.reshape(bsz, t, MIX_W) * g

    pc, pl = prep(u_ctx), prep(u_lat)
    bsz = u_lat.shape[0]
    s_zero = jnp.zeros((bsz, N_HEADS, HEAD_DIM, HEAD_DIM), jnp.float32)
    y_c, y_l = [], []
    for d in range(2):
        yc, st = run(pc, d, s_zero)
        yl, _ = run(pl, d, st)
        y_c.append(yc)
        y_l.append(yl)
    out_lat = finish(y_l[0] + y_l[1], pl).astype(u_lat.dtype)
    out_ctx = finish(y_c[0] + y_c[1], pc).astype(u_ctx.dtype) if need_ctx else None
    return out_ctx, out_lat


def _mla_mixer(u_ctx, u_lat, need_ctx, rope_tabs, qn_g, kvn_g, wuq, wuk, wuv):
    def prep(u):
        bsz, t = u.shape[:2]
        cq, ckv, kr = _split(u, (Q_LORA, KV_LORA, QK_ROPE))
        q = (_rms_norm(cq, qn_g) @ wuq).reshape(bsz, t, N_HEADS, QK_NOPE + QK_ROPE)
        ckv = _rms_norm(ckv, kvn_g)
        k_nope = (ckv @ wuk).reshape(bsz, t, N_HEADS, QK_NOPE)
        v = (ckv @ wuv).reshape(bsz, t, N_HEADS, V_HEAD)
        return q, k_nope, kr[:, :, None, :], v

    def keys(k_nope, k_rope):
        return jnp.concatenate([k_nope, jnp.broadcast_to(k_rope, k_nope.shape[:3] + (QK_ROPE,))], -1)

    scale = (QK_NOPE + QK_ROPE) ** -0.5
    qc, knc, krc, vc = prep(u_ctx)
    ql, knl, krl, vl = prep(u_lat)
    ql = jnp.concatenate([ql[..., :QK_NOPE], _axial_rope(ql[..., QK_NOPE:], rope_tabs)], -1)
    kc = keys(knc, krc)
    kl = keys(knl, _axial_rope(krl, rope_tabs))
    k_all = jnp.concatenate([kc, kl], 1)
    v_all = jnp.concatenate([vc, vl], 1)
    bsz, t = ql.shape[:2]
    qb = ql.reshape(bsz, t // Q_BLOCK, Q_BLOCK, N_HEADS, QK_NOPE + QK_ROPE).swapaxes(0, 1)
    o_lat = lax.map(lambda q_blk: _attend(q_blk, k_all, v_all, scale), qb)
    o_lat = o_lat.swapaxes(0, 1).reshape(bsz, t, N_HEADS * V_HEAD)
    o_ctx = _attend(qc, kc, vc, scale).reshape(bsz, -1, N_HEADS * V_HEAD) if need_ctx else None
    return o_ctx, o_lat


def _linear_scan(a, b, h0):
    def comb(e1, e2):
        a1, b1 = e1
        a2, b2 = e2
        return a1 * a2, a2 * b1 + b2
    a_cum, b_cum = lax.associative_scan(comb, (a, b), axis=1)
    h = b_cum + a_cum * h0[:, None, :]
    return h, h[:, -1]


def _rglru_mixer(u_ctx, u_lat, need_ctx, conv_w, conv_b, wa, ba, wx, bx, lam):
    def conv(u):
        y = lax.conv_general_dilated(u.astype(jnp.float32), conv_w.astype(jnp.float32)[:, None, :], (1,),
                                     [(CONV_W // 2, CONV_W - 1 - CONV_W // 2)],
                                     dimension_numbers=('NWC', 'WIO', 'NWC'), feature_group_count=MIX_W)
        return y + conv_b

    def coeffs(xc, d):
        bsz, t = xc.shape[:2]
        xb = xc.reshape(bsz, t, LRU_BLOCKS, LRU_BS)
        r = jax.nn.sigmoid(jnp.einsum('btni,nij->btnj', xb, wa[d]).reshape(bsz, t, MIX_W) + ba[d])
        i = jax.nn.sigmoid(jnp.einsum('btni,nij->btnj', xb, wx[d]).reshape(bsz, t, MIX_W) + bx[d])
        log_a = -LRU_C * r * jax.nn.softplus(-lam[d])
        return jnp.exp(log_a), jnp.sqrt(-jnp.expm1(2.0 * log_a)) * (i * xc)

    xc_c, xc_l = conv(u_ctx), conv(u_lat)
    h0 = jnp.zeros((u_lat.shape[0], MIX_W), jnp.float32)
    h_c, h_l = [], []
    for d in range(2):
        f = lambda z, rev=(d == 1): _maybe_flip(z, 1, rev)
        a, b = coeffs(xc_c, d)
        hc, st = _linear_scan(f(a), f(b), h0)
        a, b = coeffs(xc_l, d)
        hl, _ = _linear_scan(f(a), f(b), st)
        h_c.append(f(hc))
        h_l.append(f(hl))
    out_lat = (h_l[0] + h_l[1]).astype(u_lat.dtype)
    out_ctx = (h_c[0] + h_c[1]).astype(u_ctx.dtype) if need_ctx else None
    return out_ctx, out_lat


def _merge(gate_u, outs, w_branch, w_out):
    bsz, t = gate_u.shape[:2]
    gates = jax.nn.sigmoid(gate_u).reshape(bsz, t, N_BRANCH, D_MODEL)
    o = jnp.stack(outs, axis=2)
    y = jnp.einsum('btnm,nmd->btnd', o, w_branch)
    return jnp.einsum('btnd,de->bte', gates * y, w_out)


def _mixing_sublayer(h_ctx, h_lat, need_ctx, rope_tabs, w_in, mlstm_gate_b, mlstm_norm_g, rwkv_mu,
                     rwkv_w0, rwkv_w2, rwkv_a0, rwkv_a2, rwkv_g2, rwkv_kk, rwkv_ka, rwkv_rk, rwkv_gn_g,
                     mla_qn_g, mla_kvn_g, mla_wuq, mla_wuk, mla_wuv, lru_conv_w, lru_conv_b, lru_wa,
                     lru_ba, lru_wx, lru_bx, lru_lambda, w_branch, w_out):
    g_c, ml_c, rw_c, mla_c, lru_c = _split(h_ctx @ w_in, IN_WIDTHS)
    g_l, ml_l, rw_l, mla_l, lru_l = _split(h_lat @ w_in, IN_WIDTHS)
    a_c, a_l = _mlstm_mixer(ml_c, ml_l, need_ctx, mlstm_gate_b, mlstm_norm_g)
    b_c, b_l = _rwkv7_mixer(rw_c, rw_l, need_ctx, rwkv_mu, rwkv_w0, rwkv_w2, rwkv_a0, rwkv_a2, rwkv_g2,
                            rwkv_kk, rwkv_ka, rwkv_rk, rwkv_gn_g)
    c_c, c_l = _mla_mixer(mla_c, mla_l, need_ctx, rope_tabs, mla_qn_g, mla_kvn_g, mla_wuq, mla_wuk, mla_wuv)
    d_c, d_l = _rglru_mixer(lru_c, lru_l, need_ctx, lru_conv_w, lru_conv_b, lru_wa, lru_ba, lru_wx, lru_bx,
                            lru_lambda)
    y_lat = _merge(g_l, (a_l, b_l, c_l, d_l), w_branch, w_out)
    y_ctx = _merge(g_c, (a_c, b_c, c_c, d_c), w_branch, w_out) if need_ctx else None
    return y_ctx, y_lat


def _sq_relu_mlp(h, w1, w2):
    return jnp.square(jax.nn.relu(h @ w1)) @ w2


def setup_inputs(seed: int = 0) -> dict:
    key = jax.random.key(seed)
    ks = iter(jax.random.split(key, 64))

    def nrm(shape, scale):
        return jax.random.normal(next(ks), shape, jnp.float32) * scale

    def near_one(shape):
        return 1.0 + nrm(shape, 0.02)

    L = DEPTH
    x = nrm((BATCH, SEQ, D_MODEL), 1.0)
    c = nrm((BATCH, D_MODEL), 1.0)
    ctx = nrm((BATCH, CTX_LEN, D_MODEL), 1.0)
    c_ctx = nrm((D_MODEL,), 1.0)
    w_mod = nrm((L, D_MODEL, 6 * D_MODEL), 0.5 * D_MODEL ** -0.5)
    b_mod = nrm((L, 6 * D_MODEL), 0.02)
    w_in = nrm((L, D_MODEL, D_IN), D_MODEL ** -0.5)
    f_base = jnp.linspace(3.0, 6.0, N_HEADS, dtype=jnp.float32)
    mlstm_gate_b = jnp.concatenate([nrm((L, 2, 1, N_HEADS), 0.1),
                                    f_base + nrm((L, 2, 1, N_HEADS), 0.1)], axis=2)
    mlstm_norm_g = near_one((L, MIX_W))
    rwkv_mu = jax.random.uniform(next(ks), (L, RWKV_COLS), jnp.float32, 0.1, 0.9)
    ramp = jnp.arange(MIX_W, dtype=jnp.float32) / (MIX_W - 1)
    rwkv_w0 = -6.5 + 5.0 * ramp ** 0.85 + nrm((L, 2, MIX_W), 0.1)
    rwkv_w2 = nrm((L, 2, DECAY_LORA, MIX_W), 0.5 * DECAY_LORA ** -0.5)
    rwkv_a0 = nrm((L, 2, MIX_W), 0.1)
    rwkv_a2 = nrm((L, 2, ICLR_LORA, MIX_W), 0.5 * ICLR_LORA ** -0.5)
    rwkv_g2 = nrm((L, GATE_LORA, MIX_W), GATE_LORA ** -0.5)
    rwkv_kk = 0.85 + nrm((L, MIX_W), 0.02)
    rwkv_ka = near_one((L, MIX_W))
    rwkv_rk = nrm((L, N_HEADS, HEAD_DIM), 0.1)
    rwkv_gn_g = near_one((L, MIX_W))
    mla_qn_g = near_one((L, Q_LORA))
    mla_kvn_g = near_one((L, KV_LORA))
    mla_wuq = nrm((L, Q_LORA, N_HEADS * (QK_NOPE + QK_ROPE)), Q_LORA ** -0.5)
    mla_wuk = nrm((L, KV_LORA, N_HEADS * QK_NOPE), KV_LORA ** -0.5)
    mla_wuv = nrm((L, KV_LORA, N_HEADS * V_HEAD), KV_LORA ** -0.5)
    lru_conv_w = nrm((L, CONV_W, MIX_W), CONV_W ** -0.5)
    lru_conv_b = nrm((L, MIX_W), 0.02)
    lru_wa = nrm((L, 2, LRU_BLOCKS, LRU_BS, LRU_BS), LRU_BS ** -0.5)
    lru_ba = nrm((L, 2, MIX_W), 0.1)
    lru_wx = nrm((L, 2, LRU_BLOCKS, LRU_BS, LRU_BS), LRU_BS ** -0.5)
    lru_bx = nrm((L, 2, MIX_W), 0.1)
    a_pow = jax.random.uniform(next(ks), (L, 2, MIX_W), jnp.float32, 0.9, 0.999)
    a_base = a_pow ** (1.0 / LRU_C)
    lru_lambda = jnp.log(a_base) - jnp.log1p(-a_base)
    w_branch = nrm((L, N_BRANCH, MIX_W, D_MODEL), MIX_W ** -0.5)
    w_out = nrm((L, D_MODEL, D_MODEL), BETA * D_MODEL ** -0.5)
    ln1_g = near_one((L, D_MODEL))
    ln1_b = nrm((L, D_MODEL), 0.02)
    w_ff1 = nrm((L, D_MODEL, D_FF), D_MODEL ** -0.5)
    w_ff2 = nrm((L, D_FF, D_MODEL), BETA * D_FF ** -0.5)
    ln2_g = near_one((L, D_MODEL))
    ln2_b = nrm((L, D_MODEL), 0.02)
    return {'x': x, 'c': c, 'ctx': ctx, 'c_ctx': c_ctx, 'w_mod': w_mod, 'b_mod': b_mod, 'w_in': w_in,
            'mlstm_gate_b': mlstm_gate_b, 'mlstm_norm_g': mlstm_norm_g, 'rwkv_mu': rwkv_mu,
            'rwkv_w0': rwkv_w0, 'rwkv_w2': rwkv_w2, 'rwkv_a0': rwkv_a0, 'rwkv_a2': rwkv_a2,
            'rwkv_g2': rwkv_g2, 'rwkv_kk': rwkv_kk, 'rwkv_ka': rwkv_ka, 'rwkv_rk': rwkv_rk,
            'rwkv_gn_g': rwkv_gn_g, 'mla_qn_g': mla_qn_g, 'mla_kvn_g': mla_kvn_g, 'mla_wuq': mla_wuq,
            'mla_wuk': mla_wuk, 'mla_wuv': mla_wuv, 'lru_conv_w': lru_conv_w, 'lru_conv_b': lru_conv_b,
            'lru_wa': lru_wa, 'lru_ba': lru_ba, 'lru_wx': lru_wx, 'lru_bx': lru_bx,
            'lru_lambda': lru_lambda, 'w_branch': w_branch, 'w_out': w_out, 'ln1_g': ln1_g,
            'ln1_b': ln1_b, 'w_ff1': w_ff1, 'w_ff2': w_ff2, 'ln2_g': ln2_g, 'ln2_b': ln2_b}


def reference(x, c, ctx, c_ctx, w_mod, b_mod, w_in, mlstm_gate_b, mlstm_norm_g, rwkv_mu, rwkv_w0, rwkv_w2,
              rwkv_a0, rwkv_a2, rwkv_g2, rwkv_kk, rwkv_ka, rwkv_rk, rwkv_gn_g, mla_qn_g, mla_kvn_g, mla_wuq,
              mla_wuk, mla_wuv, lru_conv_w, lru_conv_b, lru_wa, lru_ba, lru_wx, lru_bx, lru_lambda, w_branch,
              w_out, ln1_g, ln1_b, w_ff1, w_ff2, ln2_g, ln2_b):
    rows = x.shape[1] // GRID_W
    rope_tabs = _axial_rope_tables(rows)
    s_lat = jax.nn.silu(c)
    s_ctx = jax.nn.silu(c_ctx)
    x_lat, x_ctx = x, ctx
    for l in range(DEPTH):
        need_ctx = l < DEPTH - 1
        m_lat = jnp.split((s_lat @ w_mod[l] + b_mod[l])[:, None, :], 6, axis=-1)
        m_ctx = jnp.split((s_ctx @ w_mod[l] + b_mod[l])[None, None, :], 6, axis=-1)
        h_lat = _modulate(x_lat, m_lat[0], m_lat[1])
        h_ctx = _modulate(x_ctx, m_ctx[0], m_ctx[1])
        y_ctx, y_lat = _mixing_sublayer(
            h_ctx, h_lat, need_ctx, rope_tabs, w_in[l], mlstm_gate_b[l], mlstm_norm_g[l], rwkv_mu[l],
            rwkv_w0[l], rwkv_w2[l], rwkv_a0[l], rwkv_a2[l], rwkv_g2[l], rwkv_kk[l], rwkv_ka[l], rwkv_rk[l],
            rwkv_gn_g[l], mla_qn_g[l], mla_kvn_g[l], mla_wuq[l], mla_wuk[l], mla_wuv[l], lru_conv_w[l],
            lru_conv_b[l], lru_wa[l], lru_ba[l], lru_wx[l], lru_bx[l], lru_lambda[l], w_branch[l], w_out[l])
        x_lat = _layer_norm(ALPHA * x_lat + m_lat[2] * y_lat, ln1_g[l], ln1_b[l])
        f_lat = _sq_relu_mlp(_modulate(x_lat, m_lat[3], m_lat[4]), w_ff1[l], w_ff2[l])
        x_lat = _layer_norm(ALPHA * x_lat + m_lat[5] * f_lat, ln2_g[l], ln2_b[l])
        if need_ctx:
            x_ctx = _layer_norm(ALPHA * x_ctx + m_ctx[2] * y_ctx, ln1_g[l], ln1_b[l])
            f_ctx = _sq_relu_mlp(_modulate(x_ctx, m_ctx[3], m_ctx[4]), w_ff1[l], w_ff2[l])
            x_ctx = _layer_norm(ALPHA * x_ctx + m_ctx[5] * f_ctx, ln2_g[l], ln2_b[l])
    return x_lat
```

```cpp
#include <hip/hip_runtime.h>
#include <hip/hip_cooperative_groups.h>
#include <cstdio>
#include <cstdint>
namespace cg = cooperative_groups;

#define LAS __attribute__((address_space(3)))
typedef unsigned short bf16_t;
typedef short bf16x8 __attribute__((ext_vector_type(8)));
typedef short s16x4 __attribute__((ext_vector_type(4)));
typedef float f32x4 __attribute__((ext_vector_type(4)));
typedef unsigned u32x4 __attribute__((ext_vector_type(4)));
typedef unsigned u32x2 __attribute__((ext_vector_type(2)));

constexpr int D = 1024, NB = 4, T = 4096, TC = 256, ML = NB * T, MC = NB * TC, M = ML + MC, NLAY = 4;
constexpr int NU = 3584, NG = 4096, DIN = 6704;
constexpr int U_ML = 0, U_RW = 1040, U_MLA = 2000, U_LRU = 2352, U_Q = 2608, U_KN = 2992, U_V = 3248;
constexpr int NKEY = T + TC;
constexpr float ALPHA = 1.681792830507429f;
constexpr float LOG2E = 1.4426950408889634f;

constexpr size_t al256(size_t x) { return (x + 255) & ~(size_t)255; }
constexpr size_t WS_CTL = 0;
constexpr size_t WS_MOD = 4096;
constexpr size_t WS_WG = al256(WS_MOD + (size_t)NLAY * 5 * 6144 * 4);
constexpr size_t WS_WU = WS_WG + (size_t)4096 * 1024 * 2;
constexpr size_t WS_WBR = WS_WU + (size_t)NU * 1024 * 2;
constexpr size_t WS_WO = WS_WBR + (size_t)4096 * 256 * 2;
constexpr size_t WS_W1 = WS_WO + (size_t)1024 * 1024 * 2;
constexpr size_t WS_W2 = WS_W1 + (size_t)4096 * 1024 * 2;
constexpr size_t WS_A = WS_W2 + (size_t)4096 * 1024 * 2;
constexpr size_t WS_YR = WS_A + (size_t)M * NU * 2;
constexpr size_t WS_H = WS_A + (size_t)M * 4096 * 2;
constexpr size_t WS_XB = WS_H + (size_t)M * 1024 * 2;
constexpr size_t WS_RKR = WS_XB + (size_t)M * 1024 * 4;
constexpr size_t WS_RKKK = WS_RKR + (size_t)M * 256 * 2;
constexpr size_t WS_RKV = WS_RKKK + (size_t)M * 256 * 2;
constexpr size_t WS_GRW = WS_RKV + (size_t)M * 256 * 2;
constexpr size_t WS_BON = WS_GRW + (size_t)M * 256 * 2;
constexpr size_t WS_RKW = WS_BON + (size_t)M * 4 * 4;
constexpr size_t WS_RKB = WS_RKW + (size_t)M * 512 * 2;
constexpr size_t WS_RKK = WS_RKB + (size_t)M * 512 * 2;
constexpr size_t WS_OC = WS_RKW;
constexpr size_t WS_VT = WS_RKK + (size_t)M * 512 * 2;
constexpr size_t WS_AO = WS_VT + (size_t)16 * 64 * NKEY * 2;
constexpr size_t WS_CL = WS_AO + (size_t)M * 256 * 2;
constexpr size_t WS_NL = WS_CL + (size_t)1088 * 4096 * 2;
constexpr size_t WS_SC = WS_NL + (size_t)1088 * 64 * 4;
constexpr size_t WS_LS = WS_SC + (size_t)1088 * 4 * 4;
constexpr size_t WS_END = WS_LS + (size_t)1088 * 128 * 4;
static_assert(WS_END < (size_t)440 * 1000 * 1000, "d_ws map too large");
static_assert((size_t)M * 1024 * 2 <= (size_t)M * 512 * 2 * 3, "OC overlay");
constexpr int LDS_BYTES = 147456;

struct Args { const float* in[39]; float* out; unsigned char* ws; };
typedef const __attribute__((address_space(4))) Args* ArgsP;
__device__ __forceinline__ int otid() { int t = threadIdx.x; asm volatile("" : "+v"(t)); return t; }
__device__ __forceinline__ int obid() { int t = blockIdx.x; asm volatile("" : "+s"(t)); return t; }
#define LAUNDER(p) asm volatile("" : "+s"(p))

__device__ __forceinline__ float bf2f(bf16_t v) { return __uint_as_float((unsigned)v << 16); }
__device__ __forceinline__ unsigned f2bf(float f) { unsigned u = __float_as_uint(f); return (u + 0x7fffu + ((u >> 16) & 1u)) >> 16; }
__device__ __forceinline__ unsigned pk2(float lo, float hi) { return f2bf(lo) | (f2bf(hi) << 16); }
__device__ __forceinline__ float sigmoidf_(float x) { return 1.0f / (1.0f + __expf(-x)); }
__device__ __forceinline__ float softplusf_(float x) { return fmaxf(x, 0.f) + log1pf(__expf(-fabsf(x))); }
__device__ __forceinline__ float wave_sum(float v) {
#pragma unroll
    for (int o = 1; o < 64; o <<= 1) v += __shfl_xor(v, o);
    return v;
}
__device__ __forceinline__ float dpp_add16(float x) {
    x += __int_as_float(__builtin_amdgcn_update_dpp(0, __float_as_int(x), 0xB1, 0xF, 0xF, false));
    x += __int_as_float(__builtin_amdgcn_update_dpp(0, __float_as_int(x), 0x4E, 0xF, 0xF, false));
    x += __int_as_float(__builtin_amdgcn_update_dpp(0, __float_as_int(x), 0x141, 0xF, 0xF, false));
    x += __int_as_float(__builtin_amdgcn_update_dpp(0, __float_as_int(x), 0x140, 0xF, 0xF, false));
    return x;
}
__device__ __forceinline__ f32x4 mma16(const bf16_t* A, int lda, int r0, const bf16_t* Bt, int ldb, int c0, int K, int lane) {
    const int fr = lane & 15, fq = lane >> 4;
    f32x4 acc = {0.f, 0.f, 0.f, 0.f};
    const bf16_t* ap = A + (r0 + fr) * lda + fq * 8;
    const bf16_t* bp = Bt + (c0 + fr) * ldb + fq * 8;
    for (int k0 = 0; k0 < K; k0 += 32) {
        const bf16x8 a = *(const bf16x8*)(ap + k0);
        const bf16x8 b = *(const bf16x8*)(bp + k0);
        acc = __builtin_amdgcn_mfma_f32_16x16x32_bf16(a, b, acc, 0, 0, 0);
    }
    return acc;
}

namespace pg8 {
constexpr int BM = 256, BK = 64, HALF = 128, HTB = HALF * BK * 2, STAGE_BYTES = 8 * HTB, NXCD = 8, WGM = 8;
__host__ __device__ __forceinline__ int lds_byte(int r, int c) { const int st = (r >> 4) * 2 + (c >> 5), rr = r & 15, cc = c & 31, ob = rr * 64 + cc * 2; return st * 1024 + (ob ^ (((ob >> 9) & 1) << 5)); }
__host__ __device__ __forceinline__ void stage_rc(int b, int& R, int& C) { const int st = b / 1024, sb = b % 1024, swz = sb ^ (((sb >> 9) & 1) << 5); R = (st >> 1) * 16 + swz / 64; C = (st & 1) * 32 + (swz % 64) / 2; }
__host__ __device__ __forceinline__ int perm32(int rho) { const int n = rho >> 4, i = rho & 15; return 8 * (i >> 2) + 4 * n + (i & 3); }
struct Unit { int pm, pn; };
struct Gemm { const bf16_t* A; const bf16_t* Bt; int lda, ldb, K, bmask, astep; };
struct StaticOrder {
    int nM, nN, nwg, G, c;
    __device__ void init(int nM_, int nN_, int G_, int c_) { nM = nM_; nN = nN_; nwg = nM * nN; G = G_; c = c_; }
    __device__ bool next(int i, Unit& u) const {
        const long L = (long)i * G + c; if (L >= nwg) return false;
        int wgid = (int)L; { const int q = nwg / NXCD, r = nwg % NXCD, xcd = wgid % NXCD, off = wgid / NXCD; wgid = (xcd < r ? xcd * (q + 1) : r * (q + 1) + (xcd - r) * q) + off; }
        const int nig = WGM * nN, gid = wgid / nig, fm = gid * WGM, gsz = (nM - fm) < WGM ? (nM - fm) : WGM;
        u.pm = fm + ((wgid % nig) % gsz); u.pn = (wgid % nig) / gsz; return true;
    }
};
__device__ __forceinline__ unsigned cvt_pk_bf16(float lo, float hi) { unsigned r; asm volatile("v_cvt_pk_bf16_f32 %0, %1, %2" : "=v"(r) : "v"(lo), "v"(hi)); return r; }

template <int ACT> struct EpiB {
    static constexpr bool PERM = true;
    bf16_t* O; int ldc;
    __device__ __forceinline__ void operator()(const f32x4 (&acc)[2][2][4][2], const Unit& u, int wr, int wc, int fr, int fq) const {
        const int row0 = u.pm * BM + wr * 64 + fr; const int col0 = u.pn * BM + wc * 32 + 8 * fq;
#pragma unroll
        for (int ai = 0; ai < 2; ++ai)
#pragma unroll
            for (int m = 0; m < 4; ++m) { bf16_t* rowp = O + (size_t)(row0 + ai * HALF + m * 16) * ldc + col0;
#pragma unroll
                for (int bj = 0; bj < 2; ++bj) { f32x4 v0 = acc[ai][bj][m][0], v1 = acc[ai][bj][m][1];
                    if (ACT == 1) {
#pragma unroll
                        for (int e = 0; e < 4; ++e) { float a = fmaxf(v0[e], 0.f), b = fmaxf(v1[e], 0.f); v0[e] = a * a; v1[e] = b * b; }
                    }
                    if (ACT == 2) { const u32x4 y = *(const u32x4*)(rowp + bj * HALF);
#pragma unroll
                        for (int e = 0; e < 4; ++e) { const unsigned yw0 = y[e >> 1], yw1 = y[2 + (e >> 1)];
                            const float y0 = (e & 1) ? __uint_as_float(yw0 & 0xffff0000u) : __uint_as_float(yw0 << 16);
                            const float y1 = (e & 1) ? __uint_as_float(yw1 & 0xffff0000u) : __uint_as_float(yw1 << 16);
                            v0[e] = sigmoidf_(v0[e]) * y0; v1[e] = sigmoidf_(v1[e]) * y1; }
                    }
                    u32x4 w; w.x = cvt_pk_bf16(v0[0], v0[1]); w.y = cvt_pk_bf16(v0[2], v0[3]); w.z = cvt_pk_bf16(v1[0], v1[1]); w.w = cvt_pk_bf16(v1[2], v1[3]);
                    *(u32x4*)(rowp + bj * HALF) = w; }
                if (ACT == 2) asm volatile("" ::: "memory"); }
    }
};
struct EpiRes {
    static constexpr bool PERM = false;
    float* X; const float* gate;
    __device__ __forceinline__ void operator()(const f32x4 (&acc)[2][2][4][2], const Unit& u, int wr, int wc, int fr, int fq) const {
        const int s = u.pm < 64 ? (u.pm >> 4) : 4; const float* g = gate + s * 6144;
        const int col0 = u.pn * BM + wc * 32 + 4 * fq;
#pragma unroll
        for (int bj = 0; bj < 2; ++bj)
#pragma unroll
            for (int n = 0; n < 2; ++n) { const f32x4 gv = *(const f32x4*)(g + col0 + bj * HALF + n * 16);
#pragma unroll
                for (int ai = 0; ai < 2; ++ai) {
#pragma unroll
                    for (int m = 0; m < 4; ++m) { float* p = X + (size_t)(u.pm * BM + ai * HALF + wr * 64 + m * 16 + fr) * D + col0 + bj * HALF + n * 16;
                        const f32x4 x = *(const f32x4*)p; *(f32x4*)p = x * ALPHA + gv * acc[ai][bj][m][n]; }
                    asm volatile("" ::: "memory"); } }
    }
};

template <class Epi, class Sched, bool ALIGN_EPI, bool SP2>
__device__ __forceinline__ void gemm_phase(LAS unsigned char* lds, const Gemm g, const Sched& S, const Epi& E) {
    const int tid = otid(), wid = __builtin_amdgcn_readfirstlane(tid >> 6), lane = tid & 63, wr = wid >> 2, wc = wid & 3, fr = lane & 15, fq = lane >> 4;
    const int K = g.K, nt = K / BK;
    unsigned voffA[2], voffB[2];
#pragma unroll
    for (int i = 0; i < 2; ++i) { int R, C; stage_rc(tid * 16 + i * 8192, R, C); const int Rb = Epi::PERM ? ((R & ~31) + perm32(R & 31)) : R;
        voffA[i] = (unsigned)(R * g.lda + C) * 2u; voffB[i] = (unsigned)(Rb * g.ldb + C) * 2u; }
    const size_t kstep = (size_t)(BK * 2);
    const size_t hstepA = (size_t)HALF * g.lda * 2, hstepB = (size_t)HALF * g.ldb * 2;
    const size_t tstepA = 2 * hstepA, tstepB = 2 * hstepB;
    const unsigned ldsw = (unsigned)wid * 1024u;
    const int aoff = lds_byte(wr * 64 + fr, fq * 8), boff = lds_byte(wc * 32 + fr, fq * 8);
    const int bmask = g.bmask;
#define PG8_SA(b, h) (((b) * 2 + (h)) * HTB)
#define PG8_SB(b, h) ((4 + (b) * 2 + (h)) * HTB)
#define PG8_STAGE(bufoff, gbase, voff) do { _Pragma("unroll") for (int _i = 0; _i < 2; ++_i) \
        __builtin_amdgcn_global_load_lds((const unsigned*)((const char*)(gbase) + (voff)[_i]), (LAS unsigned*)(lds + (bufoff) + ldsw + _i * 8192), 16, 0, 0); } while (0)
#define PG8_LDA(dst, b, h) do { _Pragma("unroll") for (int m = 0; m < 4; ++m) _Pragma("unroll") for (int k = 0; k < 2; ++k) dst[m][k] = *(const LAS bf16x8*)(lds + PG8_SA(b, h) + aoff + m * 2048 + k * 1024); } while (0)
#define PG8_LDB(dst, b, h) do { _Pragma("unroll") for (int n = 0; n < 2; ++n) _Pragma("unroll") for (int k = 0; k < 2; ++k) dst[n][k] = *(const LAS bf16x8*)(lds + PG8_SB(b, h) + boff + n * 2048 + k * 1024); } while (0)
#define PG8_MMA(ai, bj, At, Bt) do { __builtin_amdgcn_s_setprio(1); _Pragma("unroll") for (int m = 0; m < 4; ++m) _Pragma("unroll") for (int n = 0; n < 2; ++n) _Pragma("unroll") for (int k = 0; k < 2; ++k) \
        acc[ai][bj][m][n] = __builtin_amdgcn_mfma_f32_16x16x32_bf16(Bt[n][k], At[m][k], acc[ai][bj][m][n], 0, 0, 0); __builtin_amdgcn_s_setprio(0); } while (0)
#define PG8_WAIT_V(n) asm volatile("s_waitcnt vmcnt(" #n ")" ::: "memory")
#define PG8_WAIT_L(n) asm volatile("s_waitcnt lgkmcnt(" #n ")" ::: "memory")
#define PG8_BAR __builtin_amdgcn_s_barrier()
#define PG8_SCHED __builtin_amdgcn_sched_barrier(0)
    Unit cur, nxt; int ui = 0;
    if (!S.next(0, cur)) return;
    f32x4 acc[2][2][4][2];
#pragma unroll
    for (int a = 0; a < 2; ++a)
#pragma unroll
        for (int b = 0; b < 2; ++b)
#pragma unroll
            for (int m = 0; m < 4; ++m)
#pragma unroll
                for (int n = 0; n < 2; ++n) acc[a][b][m][n] = (f32x4){0.f, 0.f, 0.f, 0.f};
    bf16x8 At[4][2], B0[2][2], B1[2][2];
    const char* cA = (const char*)g.A + (size_t)cur.pm * tstepA + (size_t)((cur.pn >> 2) * g.astep) * 2; const char* cB = (const char*)g.Bt + (size_t)cur.pn * tstepB;
    if constexpr (SP2) {
        PG8_STAGE(PG8_SB(0, 0), cB, voffB); PG8_STAGE(PG8_SB(0, 1), cB + hstepB, voffB); PG8_STAGE(PG8_SA(0, 0), cA, voffA); PG8_STAGE(PG8_SA(0, 1), cA + hstepA, voffA);
        if (wr == 1) PG8_BAR;
        PG8_WAIT_V(2); PG8_BAR;
        PG8_STAGE(PG8_SB(1, 0), cB + kstep, voffB); PG8_STAGE(PG8_SA(1, 0), cA + kstep, voffA); PG8_STAGE(PG8_SB(1, 1), cB + hstepB + kstep, voffB);
        PG8_WAIT_V(6); PG8_BAR;
    } else {
        PG8_STAGE(PG8_SB(0, 0), cB, voffB); PG8_STAGE(PG8_SA(0, 0), cA, voffA); PG8_STAGE(PG8_SB(0, 1), cB + hstepB, voffB); PG8_STAGE(PG8_SA(0, 1), cA + hstepA, voffA);
        if (wr == 1) PG8_BAR;
        PG8_WAIT_V(4); PG8_BAR;
        PG8_STAGE(PG8_SB(1, 0), cB + kstep, voffB); PG8_STAGE(PG8_SA(1, 0), cA + kstep, voffA); PG8_STAGE(PG8_SB(1, 1), cB + hstepB + kstep, voffB);
        PG8_WAIT_V(6); PG8_BAR;
    }
    for (;;) {
        const bool has_next = S.next(ui + 1, nxt);
        const char* nA = has_next ? (const char*)g.A + (size_t)nxt.pm * tstepA + (size_t)((nxt.pn >> 2) * g.astep) * 2 : cA; const char* nB = has_next ? (const char*)g.Bt + (size_t)nxt.pn * tstepB : cB;
        for (int t = 0; t < nt; t += 2) {
            const bool last = (t == nt - 2);
            const char* a1 = cA + (size_t)(t + 1) * kstep;
            const char* a2 = last ? nA : cA + (size_t)(t + 2) * kstep; const char* b2 = last ? nB : cB + (size_t)((t + 2) & bmask) * kstep;
            const char* a3 = a2 + kstep; const char* b3 = last ? nB + kstep : cB + (size_t)((t + 3) & bmask) * kstep;
            if constexpr (SP2) {
            PG8_LDB(B0, 0, 0); PG8_LDB(B1, 0, 1); PG8_SCHED; PG8_LDA(At, 0, 0); PG8_STAGE(PG8_SA(1, 1), a1 + hstepA, voffA);
            PG8_WAIT_V(8); PG8_WAIT_L(0); PG8_BAR; PG8_MMA(0, 0, At, B0); PG8_MMA(0, 1, At, B1); PG8_BAR; PG8_SCHED;
            PG8_LDA(At, 0, 1); PG8_STAGE(PG8_SB(0, 0), b2, voffB); PG8_STAGE(PG8_SB(0, 1), b2 + hstepB, voffB); PG8_STAGE(PG8_SA(0, 0), a2, voffA);
            PG8_WAIT_V(8); PG8_WAIT_L(0); PG8_BAR; PG8_MMA(1, 0, At, B0); PG8_MMA(1, 1, At, B1); PG8_BAR; PG8_SCHED;
            PG8_LDB(B0, 1, 0); PG8_LDB(B1, 1, 1); PG8_SCHED; PG8_LDA(At, 1, 0); PG8_STAGE(PG8_SA(0, 1), a2 + hstepA, voffA);
            PG8_WAIT_V(8); PG8_WAIT_L(0); PG8_BAR; PG8_MMA(0, 0, At, B0); PG8_MMA(0, 1, At, B1); PG8_BAR; PG8_SCHED;
            PG8_LDA(At, 1, 1); PG8_STAGE(PG8_SB(1, 0), b3, voffB); PG8_STAGE(PG8_SB(1, 1), b3 + hstepB, voffB); PG8_STAGE(PG8_SA(1, 0), a3, voffA);
            PG8_WAIT_V(8); PG8_WAIT_L(0); PG8_BAR; PG8_MMA(1, 0, At, B0); PG8_MMA(1, 1, At, B1); PG8_BAR; PG8_SCHED;
            } else {
            PG8_LDB(B0, 0, 0); PG8_SCHED; PG8_LDA(At, 0, 0); PG8_STAGE(PG8_SA(1, 1), a1 + hstepA, voffA);
            PG8_WAIT_L(8); PG8_BAR; PG8_WAIT_L(0); PG8_MMA(0, 0, At, B0); PG8_BAR; PG8_SCHED;
            PG8_LDB(B1, 0, 1); PG8_STAGE(PG8_SB(0, 0), b2, voffB);
            PG8_BAR; PG8_WAIT_L(0); PG8_MMA(0, 1, At, B1); PG8_BAR;
            PG8_LDA(At, 0, 1); PG8_STAGE(PG8_SA(0, 0), a2, voffA);
            PG8_BAR; PG8_WAIT_L(0); PG8_MMA(1, 0, At, B0); PG8_BAR; PG8_SCHED;
            PG8_STAGE(PG8_SB(0, 1), b2 + hstepB, voffB);
            PG8_WAIT_V(6); PG8_BAR; PG8_MMA(1, 1, At, B1); PG8_BAR;
            PG8_LDB(B0, 1, 0); PG8_SCHED; PG8_LDA(At, 1, 0); PG8_STAGE(PG8_SA(0, 1), a2 + hstepA, voffA);
            PG8_WAIT_L(8); PG8_BAR; PG8_WAIT_L(0); PG8_MMA(0, 0, At, B0); PG8_BAR; PG8_SCHED;
            PG8_LDB(B1, 1, 1); PG8_STAGE(PG8_SB(1, 0), b3, voffB);
            PG8_BAR; PG8_WAIT_L(0); PG8_MMA(0, 1, At, B1); PG8_BAR;
            PG8_LDA(At, 1, 1); PG8_STAGE(PG8_SA(1, 0), a3, voffA);
            PG8_BAR; PG8_WAIT_L(0); PG8_MMA(1, 0, At, B0); PG8_BAR; PG8_SCHED;
            PG8_STAGE(PG8_SB(1, 1), b3 + hstepB, voffB);
            PG8_WAIT_V(6); PG8_BAR; PG8_MMA(1, 1, At, B1); PG8_BAR;
            }
        }
        if constexpr (ALIGN_EPI) { if (wr == 0) PG8_BAR; }
        E(acc, cur, wr, wc, fr, fq);
        if (!has_next) break;
#pragma unroll
        for (int a = 0; a < 2; ++a)
#pragma unroll
            for (int b = 0; b < 2; ++b)
#pragma unroll
                for (int m = 0; m < 4; ++m)
#pragma unroll
                    for (int n = 0; n < 2; ++n) acc[a][b][m][n] = (f32x4){0.f, 0.f, 0.f, 0.f};
        cur = nxt; cA = nA; cB = nB; ++ui;
        if constexpr (ALIGN_EPI) { if (wr == 1) PG8_BAR; }
    }
    PG8_WAIT_V(0);
    if constexpr (!ALIGN_EPI) { if (wr == 0) PG8_BAR; }
    PG8_BAR;
#undef PG8_SA
#undef PG8_SB
#undef PG8_STAGE
#undef PG8_LDA
#undef PG8_LDB
#undef PG8_MMA
#undef PG8_WAIT_V
#undef PG8_WAIT_L
#undef PG8_BAR
#undef PG8_SCHED
}
}

template <class Epi>
__device__ __forceinline__ void run_gemm(unsigned char* lds, const bf16_t* A, int lda, int astep, const bf16_t* Bt, int ldb, int K, int bmask, int nM, int nN, const Epi& E) {
    pg8::Gemm g{A, Bt, lda, ldb, K, bmask, astep};
    pg8::StaticOrder S; S.init(nM, nN, (int)gridDim.x, obid());
    pg8::gemm_phase<Epi, pg8::StaticOrder, true, true>((LAS unsigned char*)lds, g, S, E);
}

__device__ __forceinline__ void tr_item(const float* W, int ld, int c0, int ncols, bf16_t* WT, int ldo, int r0, float* scr, int kb, int nb, int lane) {
    const int k0 = 64 * kb, n0 = 32 * nb;
    const int nn = n0 + (lane & 31);
#pragma unroll 8
    for (int i = 0; i < 32; ++i) { const int kk = 2 * i + (lane >> 5); scr[kk * 33 + (lane & 31)] = (nn < ncols) ? W[(size_t)(k0 + kk) * ld + c0 + nn] : 0.f; }
    asm volatile("s_waitcnt lgkmcnt(0)" ::: "memory");
    const int c = lane & 7;
#pragma unroll
    for (int j = 0; j < 4; ++j) { const int n = (lane >> 3) + 8 * j; const float* s = scr + (8 * c) * 33 + n;
        u32x4 o; o.x = pk2(s[0 * 33], s[1 * 33]); o.y = pk2(s[2 * 33], s[3 * 33]); o.z = pk2(s[4 * 33], s[5 * 33]); o.w = pk2(s[6 * 33], s[7 * 33]);
        if (n0 + n < ncols) *(u32x4*)(WT + (size_t)(r0 + n0 + n) * ldo + k0 + 8 * c) = o; }
    asm volatile("s_waitcnt lgkmcnt(0)" ::: "memory");
}

__device__ __forceinline__ void convert_layer(ArgsP a, int l, unsigned char* lds) {
    LAUNDER(a);
    const int tid = otid(), lane = tid & 63, wave = tid >> 6;
    unsigned char* ws = a->ws;
    const float* w_in = a->in[6] + (size_t)l * 1024 * DIN;
    bf16_t* WuT = (bf16_t*)(ws + WS_WU);
    {
        float* sw = (float*)lds;
        for (int it = obid(); it < 128; it += gridDim.x) {
            const int kb = it >> 3, jc = it & 7;
            __syncthreads();
            for (int idx = tid; idx < 64 * 352; idx += 512) { const int r = idx / 352, c = idx % 352; sw[r * 353 + c] = w_in[(size_t)(kb * 64 + r) * DIN + 6096 + c]; }
            __syncthreads();
            for (int jj = 0; jj < 14; ++jj) {
                const int j = jc * 112 + wave * 14 + jj;
                const float* gv; const float* Wup; int cb, nc, ldw, col;
                if (j < 384) { gv = a->in[19] + l * 192; Wup = a->in[21] + (size_t)l * 192 * 384; cb = 0; nc = 192; ldw = 384; col = j; }
                else if (j < 640) { gv = a->in[20] + l * 128; Wup = a->in[22] + (size_t)l * 128 * 256; cb = 192; nc = 128; ldw = 256; col = j - 384; }
                else { gv = a->in[20] + l * 128; Wup = a->in[23] + (size_t)l * 128 * 256; cb = 192; nc = 128; ldw = 256; col = j - 640; }
                float acc = 0.f;
                for (int c = 0; c < nc; ++c) acc += sw[lane * 353 + cb + c] * (gv[c] * Wup[(size_t)c * ldw + col]);
                WuT[(size_t)(U_Q + j) * 1024 + kb * 64 + lane] = (bf16_t)f2bf(acc);
            }
        }
        __syncthreads();
    }
    for (int idx = obid() * 512 + tid; idx < 80 * 1024 / 8; idx += gridDim.x * 512) *(u32x4*)(WuT + (size_t)3504 * 1024 + (size_t)idx * 8) = (u32x4){0u, 0u, 0u, 0u};
    float* scr = (float*)(lds + wave * 16384);
    const int gw = obid() * 8 + wave, NGW = gridDim.x * 8;
    constexpr int I0 = 16 * 128, I1 = 16 * 82, I2 = 4 * 4 * 32, I3 = 16 * 32, I4 = 16 * 128, I5 = 64 * 32;
    constexpr int NIT = I0 + I1 + I2 + I3 + I4 + I5;
    for (int it = gw; it < NIT; it += NGW) {
        int r = it;
        if (r < I0) { tr_item(w_in, DIN, 0, 4096, (bf16_t*)(ws + WS_WG), 1024, 0, scr, r / 128, r % 128, lane); continue; } r -= I0;
        if (r < I1) { tr_item(w_in, DIN, 4096, 2608, WuT, 1024, 0, scr, r / 82, r % 82, lane); continue; } r -= I1;
        if (r < I2) { const int n = r / 128, q = r % 128; tr_item(a->in[31] + ((size_t)l * 4 + n) * 256 * 1024, 1024, 0, 1024, (bf16_t*)(ws + WS_WBR), 256, n * 1024, scr, q / 32, q % 32, lane); continue; } r -= I2;
        if (r < I3) { tr_item(a->in[32] + (size_t)l * 1024 * 1024, 1024, 0, 1024, (bf16_t*)(ws + WS_WO), 1024, 0, scr, r / 32, r % 32, lane); continue; } r -= I3;
        if (r < I4) { tr_item(a->in[35] + (size_t)l * 1024 * 4096, 4096, 0, 4096, (bf16_t*)(ws + WS_W1), 1024, 0, scr, r / 128, r % 128, lane); continue; } r -= I4;
        tr_item(a->in[36] + (size_t)l * 4096 * 1024, 1024, 0, 1024, (bf16_t*)(ws + WS_W2), 4096, 0, scr, r / 32, r % 32, lane);
    }
}

__device__ __forceinline__ void mod_partials(ArgsP a, unsigned char* lds) {
    LAUNDER(a);
    const int tid = otid(), lane = tid & 63, wave = tid >> 6;
    float* sv = (float*)lds;
    for (int idx = tid; idx < 5 * 1024; idx += 512) { const float c = idx < 4096 ? a->in[1][idx] : a->in[3][idx - 4096]; sv[idx] = c * sigmoidf_(c); }
    __syncthreads();
    float* part = (float*)(a->ws + WS_A);
    const int gw = obid() * 8 + wave, NGW = gridDim.x * 8;
    for (int it = gw; it < 4 * 16 * 96; it += NGW) {
        const int l = it / (16 * 96), ks = (it / 96) % 16, jb = it % 96;
        const int j = jb * 64 + lane;
        const float* w = a->in[4] + ((size_t)l * 1024 + ks * 64) * 6144 + j;
        float acc[5] = {0.f, 0.f, 0.f, 0.f, 0.f};
#pragma unroll 8
        for (int kk = 0; kk < 64; ++kk) { const float wv = w[(size_t)kk * 6144];
#pragma unroll
            for (int s = 0; s < 5; ++s) acc[s] += sv[s * 1024 + ks * 64 + kk] * wv; }
#pragma unroll
        for (int s = 0; s < 5; ++s) part[(((size_t)ks * 4 + l) * 5 + s) * 6144 + j] = acc[s];
    }
}
__device__ __forceinline__ void mod_finalize(ArgsP a) {
    LAUNDER(a);
    const float* part = (const float*)(a->ws + WS_A); float* mod = (float*)(a->ws + WS_MOD);
    for (int idx = obid() * 512 + otid(); idx < 4 * 5 * 6144; idx += gridDim.x * 512) {
        const int l = idx / (5 * 6144), j = idx % 6144;
        float s = a->in[5][l * 6144 + j];
        for (int ks = 0; ks < 16; ++ks) s += part[(size_t)ks * 4 * 5 * 6144 + idx];
        mod[idx] = s;
    }
}

__device__ __forceinline__ void ln_phase(ArgsP a, int mode, const float* lg, const float* lb, int lm, int si, int mrows, bool final_out) {
    LAUNDER(a);
    const int lane = otid() & 63, wave = otid() >> 6;
    const int gw = obid() * 8 + wave, NGW = gridDim.x * 8;
    float* XB = (float*)(a->ws + WS_XB); bf16_t* H = (bf16_t*)(a->ws + WS_H); const float* mod = (const float*)(a->ws + WS_MOD);
    for (int m = gw; m < mrows; m += NGW) {
        const int s = m < ML ? m / T : 4;
        const float* src = mode == 0 ? (m < ML ? a->in[0] + (size_t)m * D : a->in[2] + (size_t)(m - ML) * D) : XB + (size_t)m * D;
        f32x4 v[4];
#pragma unroll
        for (int j = 0; j < 4; ++j) v[j] = *(const f32x4*)(src + 4 * lane + 256 * j);
        if (mode == 1) {
            float sm = 0.f;
#pragma unroll
            for (int j = 0; j < 4; ++j) sm += (v[j].x + v[j].y) + (v[j].z + v[j].w);
            const float mean = wave_sum(sm) * (1.f / D); float s2 = 0.f;
#pragma unroll
            for (int j = 0; j < 4; ++j) { v[j] = v[j] - mean; s2 += (v[j].x * v[j].x + v[j].y * v[j].y) + (v[j].z * v[j].z + v[j].w * v[j].w); }
            const float rstd = 1.0f / sqrtf(wave_sum(s2) * (1.f / D) + 1e-5f);
#pragma unroll
            for (int j = 0; j < 4; ++j) { const f32x4 gg = *(const f32x4*)(lg + 4 * lane + 256 * j), bb = *(const f32x4*)(lb + 4 * lane + 256 * j); v[j] = v[j] * rstd * gg + bb; }
        }
        if (final_out) {
#pragma unroll
            for (int j = 0; j < 4; ++j) *(f32x4*)(a->out + (size_t)m * D + 4 * lane + 256 * j) = v[j];
            continue;
        }
#pragma unroll
        for (int j = 0; j < 4; ++j) *(f32x4*)(XB + (size_t)m * D + 4 * lane + 256 * j) = v[j];
        const float* sh = mod + ((size_t)lm * 5 + s) * 6144 + si * 1024; const float* sc = sh + 1024;
#pragma unroll
        for (int j = 0; j < 4; ++j) { const f32x4 s4 = *(const f32x4*)(sh + 4 * lane + 256 * j), c4 = *(const f32x4*)(sc + 4 * lane + 256 * j);
            const f32x4 h = v[j] * (c4 + 1.0f) + s4; u32x2 w; w.x = pk2(h.x, h.y); w.y = pk2(h.z, h.w);
            *(u32x2*)(H + (size_t)m * D + 4 * lane + 256 * j) = w; }
    }
}

__device__ __forceinline__ int seq_tile(int b, int dir, int p) { return dir == 0 ? (p < 2 ? 128 + b * 2 + p : b * 32 + (p - 2)) : (p < 2 ? 128 + b * 2 + (1 - p) : b * 32 + (33 - p)); }
__device__ __forceinline__ int tile_pos(int tile, int dir) { if (tile < 128) { const int c = tile & 31; return dir == 0 ? c + 2 : 33 - c; } const int c = (tile - 128) & 1; return dir == 0 ? c : 1 - c; }

__device__ __forceinline__ void rwkv_prep_tile(ArgsP a, int l, int tile, unsigned char* lds) {
    LAUNDER(a);
    float* us = (float*)lds;
    const int tid = otid();
    const int m0 = tile * 16;
    int sbase, slen; if (m0 < ML) { sbase = (m0 / T) * T; slen = T; } else { sbase = ML + ((m0 - ML) / TC) * TC; slen = TC; }
    const bf16_t* U = (const bf16_t*)(a->ws + WS_A);
    const float* mu = a->in[9] + l * 960;
    for (int idx = tid; idx < 16 * 960; idx += 512) {
        const int i = idx / 960, c = idx % 960; const int m = m0 + i, t = m - sbase;
        const float u0 = bf2f(U[(size_t)m * NU + U_RW + c]);
        const float up = t > 0 ? bf2f(U[(size_t)(m - 1) * NU + U_RW + c]) : 0.f;
        const float un = t < slen - 1 ? bf2f(U[(size_t)(m + 1) * NU + U_RW + c]) : 0.f;
        float v = u0 + mu[c] * (0.5f * (up + un) - u0);
        if (c >= 768 && c < 832) v = tanhf(v); else if (c >= 896) v = sigmoidf_(v);
        us[idx] = v;
    }
    __syncthreads();
    const int half = tid >> 8, c = tid & 255, hh = c >> 6;
    bf16_t* RKR = (bf16_t*)(a->ws + WS_RKR); bf16_t* RKKK = (bf16_t*)(a->ws + WS_RKKK); bf16_t* RKV = (bf16_t*)(a->ws + WS_RKV); bf16_t* GRW = (bf16_t*)(a->ws + WS_GRW);
    float* BON = (float*)(a->ws + WS_BON);
    bf16_t* RKW = (bf16_t*)(a->ws + WS_RKW); bf16_t* RKB = (bf16_t*)(a->ws + WS_RKB); bf16_t* RKK = (bf16_t*)(a->ws + WS_RKK);
    const float kkw = a->in[15][l * 256 + c], kaw = a->in[16][l * 256 + c], rkw = a->in[17][l * 256 + c];
    float kv[8], kkv[8];
#pragma unroll
    for (int i = 0; i < 8; ++i) {
        const int tok = half * 8 + i; const size_t m = (size_t)(m0 + tok);
        const float k = us[tok * 960 + 256 + c], r = us[tok * 960 + c], v = us[tok * 960 + 512 + c];
        const float kk = k * kkw; const float ss = wave_sum(kk * kk);
        kkv[i] = kk * (1.0f / sqrtf(fmaxf(ss, 1e-12f))); kv[i] = k;
        const float bon = wave_sum(r * k * rkw);
        RKR[m * 256 + c] = (bf16_t)f2bf(r); RKKK[m * 256 + c] = (bf16_t)f2bf(kkv[i]); RKV[m * 256 + c] = (bf16_t)f2bf(v);
        if ((c & 63) == 0) BON[m * 4 + hh] = bon;
    }
    {
        float g[8];
#pragma unroll
        for (int i = 0; i < 8; ++i) g[i] = 0.f;
        const float* g2 = a->in[14] + (size_t)l * 64 * 256 + c;
        for (int rr = 0; rr < 64; ++rr) { const float gw = g2[rr * 256];
#pragma unroll
            for (int i = 0; i < 8; ++i) g[i] += us[(half * 8 + i) * 960 + 896 + rr] * gw; }
#pragma unroll
        for (int i = 0; i < 8; ++i) GRW[(size_t)(m0 + half * 8 + i) * 256 + c] = (bf16_t)f2bf(g[i]);
    }
    for (int d = 0; d < 2; ++d) {
        float aw[8], aa[8];
#pragma unroll
        for (int i = 0; i < 8; ++i) { aw[i] = 0.f; aa[i] = 0.f; }
        const float* w2 = a->in[11] + (size_t)(l * 2 + d) * 32 * 256 + c; const float* a2 = a->in[13] + (size_t)(l * 2 + d) * 32 * 256 + c;
        for (int rr = 0; rr < 32; ++rr) { const float w2v = w2[rr * 256], a2v = a2[rr * 256];
#pragma unroll
            for (int i = 0; i < 8; ++i) { aw[i] += us[(half * 8 + i) * 960 + 768 + d * 32 + rr] * w2v; aa[i] += us[(half * 8 + i) * 960 + 832 + d * 32 + rr] * a2v; } }
        const float w0 = a->in[10][(l * 2 + d) * 256 + c], a0 = a->in[12][(l * 2 + d) * 256 + c];
#pragma unroll
        for (int i = 0; i < 8; ++i) {
            const size_t m = (size_t)(m0 + half * 8 + i);
            const float wl = w0 + aw[i]; const float wlog = -softplusf_(-wl) - 0.5f; const float e = __expf(wlog); const float om = -expm1f(-e);
            const float av = sigmoidf_(a0 + aa[i]);
            const float bb = kkv[i] * av, kd = kv[i] * (1.0f + (av - 1.0f) * kaw);
            RKW[(m * 2 + d) * 256 + c] = (bf16_t)f2bf(om); RKB[(m * 2 + d) * 256 + c] = (bf16_t)f2bf(bb); RKK[(m * 2 + d) * 256 + c] = (bf16_t)f2bf(kd);
        }
    }
    __syncthreads();
}

__device__ __forceinline__ void mla_prep_tile(ArgsP a, int tile, unsigned char* lds) {
    LAUNDER(a);
    bf16_t* vs = (bf16_t*)lds;
    const int tid = otid(), lane = tid & 63, wave = tid >> 6;
    const int m0 = tile * 64;
    bf16_t* U = (bf16_t*)(a->ws + WS_A);
    const bool is_lat = m0 < ML;
    const float qscale = 0.10206207261596577f * LOG2E;
    for (int i = 0; i < 8; ++i) {
        const int tl = wave * 8 + i; const int m = m0 + tl;
        const int t = is_lat ? (m % T) : ((m - ML) % TC);
        bf16_t* Ur = U + (size_t)m * NU;
        float ssq = 0.f;
#pragma unroll
        for (int j = 0; j < 3; ++j) { const float x = bf2f(Ur[U_MLA + lane + 64 * j]); ssq += x * x; }
        const float rs_q = 1.0f / sqrtf(wave_sum(ssq) * (1.f / 192.f) + 1e-6f);
        float ss2 = 0.f;
#pragma unroll
        for (int j = 0; j < 2; ++j) { const float x = bf2f(Ur[U_MLA + 192 + lane + 64 * j]); ss2 += x * x; }
        const float rs_kv = 1.0f / sqrtf(wave_sum(ss2) * (1.f / 128.f) + 1e-6f);
        const float prow = (float)(t >> 6), pcol = (float)(t & 63);
        float qv[6], qp[6];
#pragma unroll
        for (int j = 0; j < 6; ++j) { const int e = lane + 64 * j; const int dd = e % 96; qv[j] = bf2f(Ur[U_Q + e]);
            int pe = e; if (dd >= 64) { const int w = (dd - 64) & 15; pe = (w < 8) ? e + 8 : e - 8; } qp[j] = bf2f(Ur[U_Q + pe]); }
        float krv = 0.f, krp = 0.f;
        if (lane < 32) { krv = bf2f(Ur[U_MLA + 320 + lane]); const int w = lane & 15; krp = bf2f(Ur[U_MLA + 320 + ((w < 8) ? lane + 8 : lane - 8)]); }
        float knv[4], vv[4];
#pragma unroll
        for (int j = 0; j < 4; ++j) { knv[j] = bf2f(Ur[U_KN + lane + 64 * j]); vv[j] = bf2f(Ur[U_V + lane + 64 * j]); }
        asm volatile("s_waitcnt vmcnt(0)" ::: "memory");
#pragma unroll
        for (int j = 0; j < 6; ++j) { const int e = lane + 64 * j; const int dd = e % 96; float o = qv[j];
            if (dd >= 64 && is_lat) { const int e32 = dd - 64, grp = e32 >> 4, w = e32 & 15, ii = w & 7;
                const float ang = (grp ? pcol : prow) * exp2f(-(float)ii * 1.6609640474436813f);
                float sn, cs; sincosf(ang, &sn, &cs);
                o = (w < 8) ? qv[j] * cs - qp[j] * sn : qv[j] * cs + qp[j] * sn; }
            Ur[U_Q + e] = (bf16_t)f2bf(o * rs_q * qscale); }
        if (lane < 32) { float o = krv;
            if (is_lat) { const int grp = lane >> 4, w = lane & 15, ii = w & 7;
                const float ang = (grp ? pcol : prow) * exp2f(-(float)ii * 1.6609640474436813f);
                float sn, cs; sincosf(ang, &sn, &cs);
                o = (w < 8) ? krv * cs - krp * sn : krv * cs + krp * sn; }
            Ur[U_MLA + 320 + lane] = (bf16_t)f2bf(o); }
#pragma unroll
        for (int j = 0; j < 4; ++j) { Ur[U_KN + lane + 64 * j] = (bf16_t)f2bf(knv[j] * rs_kv); vs[tl * 264 + lane + 64 * j] = (bf16_t)f2bf(vv[j] * rs_kv); }
    }
    __syncthreads();
    {
        const int hd = tid >> 1, hf = tid & 1;
        int b, pos0; if (is_lat) { b = m0 / T; pos0 = TC + (m0 % T); } else { b = (m0 - ML) / TC; pos0 = (m0 - ML) % TC; }
        bf16_t* VT = (bf16_t*)(a->ws + WS_VT) + ((size_t)(b * 4) * 64 + hd) * NKEY + pos0 + hf * 32;
#pragma unroll
        for (int q = 0; q < 4; ++q) { unsigned w[4];
#pragma unroll
            for (int e = 0; e < 4; ++e) { const int t0 = hf * 32 + q * 8 + e * 2; w[e] = (unsigned)vs[t0 * 264 + hd] | ((unsigned)vs[(t0 + 1) * 264 + hd] << 16); }
            *(u32x4*)(VT + q * 8) = (u32x4){w[0], w[1], w[2], w[3]}; }
    }
    __syncthreads();
}

__device__ __forceinline__ void mlstm_a1(ArgsP a, int l, int item, unsigned char* lds) {
    LAUNDER(a);
    bf16_t* VTs = (bf16_t*)lds;
    bf16_t* KWT = (bf16_t*)(lds + 17408);
    float* s_li = (float*)(lds + 34816); float* s_lf = s_li + 128; float* s_bc = s_lf + 128; float* s_a = s_bc + 128; float* s_wk = s_a + 128;
    const int tid = otid(), lane = tid & 63, wave = tid >> 6;
    const int seq = item / 34, p = item % 34, b = seq >> 3, h = (seq >> 1) & 3, dir = seq & 1;
    const int m0 = seq_tile(b, dir, p) * 128;
    const bf16_t* U = (const bf16_t*)(a->ws + WS_A);
    const float* gb = a->in[7] + l * 16 + dir * 8;
    if (tid < 128) { const int tok = dir ? 127 - tid : tid; const size_t m = (size_t)(m0 + tok);
        const float xi = bf2f(U[m * NU + 1024 + dir * 8 + h]) + gb[h]; const float xf = bf2f(U[m * NU + 1024 + dir * 8 + 4 + h]) + gb[4 + h];
        s_li[tid] = xi; s_lf[tid] = -softplusf_(-xf); }
    __syncthreads();
    if (tid < 128) { float bc = 0.f; for (int s = 0; s <= tid; ++s) bc += s_lf[s]; s_bc[tid] = bc; s_a[tid] = s_li[tid] - bc; }
    __syncthreads();
    float amax = -1e30f;
#pragma unroll 8
    for (int s = 0; s < 128; ++s) amax = fmaxf(amax, s_a[s]);
    if (tid < 128) s_wk[tid] = __expf(s_a[tid] - amax);
    __syncthreads();
    for (int idx = tid; idx < 128 * 64; idx += 512) { const int i = idx >> 6, d = idx & 63; const int tok = dir ? 127 - i : i; const size_t m = (size_t)(m0 + tok);
        VTs[d * 136 + i] = U[m * NU + 512 + h * 64 + d];
        KWT[d * 136 + i] = (bf16_t)f2bf(bf2f(U[m * NU + 256 + h * 64 + d]) * 0.125f * s_wk[i]); }
    __syncthreads();
    bf16_t* CL = (bf16_t*)(a->ws + WS_CL) + (size_t)item * 4096;
    const int fr = lane & 15, fq = lane >> 4;
#pragma unroll
    for (int q = 0; q < 2; ++q) { const int id = wave * 2 + q, rt = id >> 2, ct = id & 3;
        const f32x4 acc = mma16(VTs, 136, rt * 16, KWT, 136, ct * 16, 128, lane);
#pragma unroll
        for (int j = 0; j < 4; ++j) CL[(rt * 16 + fq * 4 + j) * 64 + ct * 16 + fr] = (bf16_t)f2bf(acc[j]); }
    if (tid < 64) { float s = 0.f;
#pragma unroll 8
        for (int i = 0; i < 128; ++i) s += bf2f(KWT[tid * 136 + i]); ((float*)(a->ws + WS_NL))[(size_t)item * 64 + tid] = s; }
    if (tid == 0) { float* SC = (float*)(a->ws + WS_SC) + (size_t)item * 4; SC[0] = s_bc[127]; SC[1] = amax; }
    __syncthreads();
}

__device__ __forceinline__ void lru_fill_xc(ArgsP a, int l, int tile, int n, float* xcf, bf16_t* xcb) {
    LAUNDER(a);
    const int tid = otid(); const int m0 = tile * 128;
    int sbase, slen; if (m0 < ML) { sbase = (m0 / T) * T; slen = T; } else { sbase = ML + ((m0 - ML) / TC) * TC; slen = TC; }
    const bf16_t* U = (const bf16_t*)(a->ws + WS_A);
    for (int idx = tid; idx < 128 * 64; idx += 512) { const int tok = idx >> 6, ch = idx & 63, cgl = n * 64 + ch; const int t = m0 - sbase + tok;
        float acc = a->in[25][l * 256 + cgl];
#pragma unroll
        for (int j = 0; j < 4; ++j) { const int tt = t - 2 + j; if (tt >= 0 && tt < slen) acc += a->in[24][(l * 4 + j) * 256 + cgl] * bf2f(U[(size_t)(sbase + tt) * NU + U_LRU + cgl]); }
        xcf[idx] = acc; xcb[tok * 72 + ch] = (bf16_t)f2bf(acc); }
}
__device__ __forceinline__ void lru_ab(ArgsP a, int l, int n, int d, const float* xcf, const bf16_t* xcb, bf16_t* WaT, bf16_t* WxT, float* la, float* lb) {
    LAUNDER(a);
    const int tid = otid(), lane = tid & 63, wave = tid >> 6, fr = lane & 15, fq = lane >> 4;
    const float* wa = a->in[26] + ((size_t)((l * 2 + d) * 4 + n)) * 4096; const float* wx = a->in[28] + ((size_t)((l * 2 + d) * 4 + n)) * 4096;
    for (int idx = tid; idx < 4096; idx += 512) { const int i = idx >> 6, j = idx & 63; WaT[j * 72 + i] = (bf16_t)f2bf(wa[idx]); WxT[j * 72 + i] = (bf16_t)f2bf(wx[idx]); }
    __syncthreads();
#pragma unroll
    for (int ct = 0; ct < 4; ++ct) {
        const f32x4 accr = mma16(xcb, 72, wave * 16, WaT, 72, ct * 16, 64, lane);
        const f32x4 acci = mma16(xcb, 72, wave * 16, WxT, 72, ct * 16, 64, lane);
        const int ch = ct * 16 + fr, cgl = n * 64 + ch;
        const float ba = a->in[27][(l * 2 + d) * 256 + cgl], bx = a->in[29][(l * 2 + d) * 256 + cgl];
        const float sp = softplusf_(-a->in[30][(l * 2 + d) * 256 + cgl]);
#pragma unroll
        for (int j = 0; j < 4; ++j) { const int tok = wave * 16 + fq * 4 + j;
            const float r = sigmoidf_(accr[j] + ba), ig = sigmoidf_(acci[j] + bx);
            const float loga = -8.0f * r * sp; const float av = __expf(loga); const float bv = sqrtf(-expm1f(2.0f * loga)) * (ig * xcf[tok * 64 + ch]);
            la[tok * 64 + ch] = av; lb[tok * 64 + ch] = bv; }
        asm volatile("" ::: "memory");
    }
    __syncthreads();
}
__device__ __forceinline__ void lru_segs(int d, const float* la, const float* lb, float* segA, float* segB) {
    const int tid = otid(), ch = tid & 63, seg = tid >> 6;
    float A = 1.f, B = 0.f;
    for (int i = 0; i < 16; ++i) { const int tok = d ? (seg * 16 + 15 - i) : (seg * 16 + i); const float av = la[tok * 64 + ch], bv = lb[tok * 64 + ch]; B = av * B + bv; A *= av; }
    segA[seg * 64 + ch] = A; segB[seg * 64 + ch] = B;
}
__device__ __forceinline__ void lru_summary(ArgsP a, int l, int item, unsigned char* lds) {
    LAUNDER(a);
    const int tile = item >> 2, n = item & 3; const int tid = otid();
    float* xcf = (float*)lds; bf16_t* xcb = (bf16_t*)(lds + 32768); bf16_t* WaT = (bf16_t*)(lds + 51200); bf16_t* WxT = (bf16_t*)(lds + 60416);
    float* la = (float*)(lds + 69632); float* lb = (float*)(lds + 102400); float* segA = (float*)(lds + 135168); float* segB = segA + 512;
    lru_fill_xc(a, l, tile, n, xcf, xcb);
    __syncthreads();
    for (int d = 0; d < 2; ++d) {
        lru_ab(a, l, n, d, xcf, xcb, WaT, WxT, la, lb);
        lru_segs(d, la, lb, segA, segB);
        __syncthreads();
        if (tid < 64) { float A = 1.f, B = 0.f;
            for (int q = 0; q < 8; ++q) { const int sg = d ? 7 - q : q; const float sa = segA[sg * 64 + tid], sb = segB[sg * 64 + tid]; B = sa * B + sb; A *= sa; }
            float* LS = (float*)(a->ws + WS_LS) + ((size_t)(item * 2 + d)) * 128; LS[tid * 2] = A; LS[tid * 2 + 1] = B; }
        __syncthreads();
    }
}
__device__ __forceinline__ void lru_output(ArgsP a, int l, int item, unsigned char* lds) {
    LAUNDER(a);
    const int tile = item >> 2, n = item & 3; const int tid = otid();
    float* xcf = (float*)lds; bf16_t* xcb = (bf16_t*)(lds + 32768); bf16_t* WaT = (bf16_t*)(lds + 51200); bf16_t* WxT = (bf16_t*)(lds + 60416);
    float* la = (float*)(lds + 69632); float* lb = (float*)(lds + 102400); float* segA = (float*)(lds + 135168); float* segB = segA + 512; float* segC = segB + 512;
    const int b = tile < 128 ? (tile >> 5) : ((tile - 128) >> 1);
    lru_fill_xc(a, l, tile, n, xcf, xcb);
    __syncthreads();
    float res[16];
    const int ch = tid & 63, seg = tid >> 6;
    for (int d = 0; d < 2; ++d) {
        lru_ab(a, l, n, d, xcf, xcb, WaT, WxT, la, lb);
        lru_segs(d, la, lb, segA, segB);
        __syncthreads();
        if (tid < 64) {
            const int p = tile_pos(tile, d); float hc = 0.f;
            for (int pp = 0; pp < p; ++pp) { const int tl = seq_tile(b, d, pp); const float* LS = (const float*)(a->ws + WS_LS) + ((size_t)((tl * 4 + n) * 2 + d)) * 128; hc = LS[tid * 2] * hc + LS[tid * 2 + 1]; }
            for (int q = 0; q < 8; ++q) { const int sg = d ? 7 - q : q; segC[sg * 64 + tid] = hc; hc = segA[sg * 64 + tid] * hc + segB[sg * 64 + tid]; }
        }
        __syncthreads();
        float hcur = segC[seg * 64 + ch];
#pragma unroll
        for (int i = 0; i < 16; ++i) { const int k = d ? 15 - i : i; const int tok = seg * 16 + k; hcur = la[tok * 64 + ch] * hcur + lb[tok * 64 + ch]; if (d == 0) res[k] = hcur; else res[k] += hcur; }
        __syncthreads();
    }
    bf16_t* OC = (bf16_t*)(a->ws + WS_OC);
#pragma unroll
    for (int k = 0; k < 16; ++k) OC[(size_t)(tile * 128 + seg * 16 + k) * 1024 + 768 + n * 64 + ch] = (bf16_t)f2bf(res[k]);
}

__device__ __forceinline__ int scan_row(int b, int dir, int i) {
    if (i < TC) { const int tok = dir ? TC - 1 - i : i; return ML + b * TC + tok; }
    const int j = i - TC; const int tok = dir ? T - 1 - j : j; return b * T + tok;
}
__device__ __forceinline__ void rwkv_scan(ArgsP a, int r, unsigned char* lds) {
    LAUNDER(a);
    float* buf = (float*)lds;
    const int tid = otid(), lane = tid & 63, wave = tid >> 6;
    const int seq = r >> 1, b = seq >> 3, h = (seq >> 1) & 3, dir = seq & 1, half = r & 1;
    const int row = half * 32 + wave * 4 + (lane >> 4), c0 = (lane & 15) * 4;
    const bf16_t* RKR = (const bf16_t*)(a->ws + WS_RKR); const bf16_t* RKKK = (const bf16_t*)(a->ws + WS_RKKK); const bf16_t* RKV = (const bf16_t*)(a->ws + WS_RKV);
    const bf16_t* RKW = (const bf16_t*)(a->ws + WS_RKW); const bf16_t* RKB = (const bf16_t*)(a->ws + WS_RKB); const bf16_t* RKK = (const bf16_t*)(a->ws + WS_RKK);
    bf16_t* YR = (bf16_t*)(a->ws + WS_YR);
    const int id1 = tid + 512; const bool has1 = id1 < 768;
    auto src_of = [&](int id, int ck) -> const bf16_t* {
        const int arr = id >> 7, st = (id >> 3) & 15, part = id & 7;
        const size_t m = (size_t)scan_row(b, dir, ck * 16 + st);
        const bf16_t* p;
        switch (arr) { case 0: p = RKKK + m * 256; break; case 1: p = RKB + (m * 2 + dir) * 256; break; case 2: p = RKW + (m * 2 + dir) * 256; break;
                       case 3: p = RKK + (m * 2 + dir) * 256; break; case 4: p = RKR + m * 256; break; default: p = RKV + m * 256; break; }
        return p + h * 64 + part * 8;
    };
    auto put = [&](int id, int nb, u32x4 v) {
        const int arr = id >> 7, st = (id >> 3) & 15, part = id & 7;
        float* dst = buf + nb * 6144 + st * 384 + arr * 64 + part * 8;
        f32x4 lo, hi;
        lo.x = __uint_as_float(v.x << 16); lo.y = __uint_as_float(v.x & 0xffff0000u); lo.z = __uint_as_float(v.y << 16); lo.w = __uint_as_float(v.y & 0xffff0000u);
        hi.x = __uint_as_float(v.z << 16); hi.y = __uint_as_float(v.z & 0xffff0000u); hi.z = __uint_as_float(v.w << 16); hi.w = __uint_as_float(v.w & 0xffff0000u);
        *(f32x4*)dst = lo; *(f32x4*)(dst + 4) = hi;
    };
    u32x4 r0 = *(const u32x4*)src_of(tid, 0), r1 = (u32x4){0u, 0u, 0u, 0u};
    if (has1) r1 = *(const u32x4*)src_of(id1, 0);
    __syncthreads();
    put(tid, 0, r0); if (has1) put(id1, 0, r1);
    __syncthreads();
    float S0 = 0.f, S1 = 0.f, S2 = 0.f, S3 = 0.f;
    constexpr int NCK = NKEY / 16;
    for (int ck = 0; ck < NCK; ++ck) {
        const int cur = ck & 1;
        if (ck + 1 < NCK) { r0 = *(const u32x4*)src_of(tid, ck + 1); if (has1) r1 = *(const u32x4*)src_of(id1, ck + 1); }
        float ysave = 0.f;
        const float* base = buf + cur * 6144;
#pragma unroll
        for (int st = 0; st < 16; ++st) {
            const float* bs = base + st * 384;
            const f32x4 kk = *(const f32x4*)(bs + c0), bb = *(const f32x4*)(bs + 64 + c0), om = *(const f32x4*)(bs + 128 + c0), kd = *(const f32x4*)(bs + 192 + c0), rr = *(const f32x4*)(bs + 256 + c0);
            const float vr = bs[320 + row];
            float sa = S0 * kk.x + S1 * kk.y + S2 * kk.z + S3 * kk.w;
            sa = dpp_add16(sa);
            S0 = S0 - S0 * om.x - sa * bb.x + vr * kd.x;
            S1 = S1 - S1 * om.y - sa * bb.y + vr * kd.y;
            S2 = S2 - S2 * om.z - sa * bb.z + vr * kd.z;
            S3 = S3 - S3 * om.w - sa * bb.w + vr * kd.w;
            float y = S0 * rr.x + S1 * rr.y + S2 * rr.z + S3 * rr.w;
            y = dpp_add16(y);
            ysave = ((lane & 15) == st) ? y : ysave;
        }
        { const size_t m = (size_t)scan_row(b, dir, ck * 16 + (lane & 15)); YR[m * 512 + dir * 256 + h * 64 + row] = (bf16_t)f2bf(ysave); }
        if (ck + 1 < NCK) { put(tid, cur ^ 1, r0); if (has1) put(id1, cur ^ 1, r1); }
        __syncthreads();
    }
}

__device__ __forceinline__ void mlstm_a2(ArgsP a, int seq) {
    LAUNDER(a);
    const int tid = otid();
    bf16_t* CLb = (bf16_t*)(a->ws + WS_CL); float* NLb = (float*)(a->ws + WS_NL); float* SCb = (float*)(a->ws + WS_SC);
    float C[8]; for (int e = 0; e < 8; ++e) C[e] = 0.f;
    float nreg = 0.f, m0 = 0.f;
    for (int p = 0; p < 34; ++p) {
        const size_t item = (size_t)seq * 34 + p;
        u32x4* cp = (u32x4*)(CLb + item * 4096 + tid * 8);
        const u32x4 cl = *cp; const float nl = tid < 64 ? NLb[item * 64 + tid] : 0.f; const float g = SCb[item * 4], amax = SCb[item * 4 + 1];
        u32x4 o; o.x = pk2(C[0], C[1]); o.y = pk2(C[2], C[3]); o.z = pk2(C[4], C[5]); o.w = pk2(C[6], C[7]);
        *cp = o; if (tid < 64) NLb[item * 64 + tid] = nreg; if (tid == 0) SCb[item * 4 + 2] = m0;
        const float mloc = g + amax, m1 = fmaxf(g + m0, mloc), so = __expf(g + m0 - m1), sn = __expf(mloc - m1);
        const unsigned cw[4] = {cl.x, cl.y, cl.z, cl.w};
#pragma unroll
        for (int e = 0; e < 4; ++e) { C[2 * e] = so * C[2 * e] + sn * __uint_as_float(cw[e] << 16); C[2 * e + 1] = so * C[2 * e + 1] + sn * __uint_as_float(cw[e] & 0xffff0000u); }
        nreg = so * nreg + sn * nl; m0 = m1;
    }
}

__device__ __forceinline__ void attn_unit(ArgsP a, int u, unsigned char* lds) {
    LAUNDER(a);
    bf16_t* Kb = (bf16_t*)lds;
    bf16_t* Vb = (bf16_t*)(lds + 26624);
    const int tid = otid(), lane = tid & 63, wave = tid >> 6, fr = lane & 15, fq = lane >> 4;
    bool is_lat; int b, h, qb;
    if (u < 512) { is_lat = true; b = u >> 7; h = (u >> 5) & 3; qb = u & 31; } else { const int v = u - 512; is_lat = false; b = v >> 3; h = (v >> 1) & 3; qb = v & 1; }
    const bf16_t* U = (const bf16_t*)(a->ws + WS_A);
    const bf16_t* VT = (const bf16_t*)(a->ws + WS_VT) + (size_t)(b * 4 + h) * 64 * NKEY;
    const int qrow0 = (is_lat ? b * T : ML + b * TC) + qb * 128 + wave * 16;
    bf16x8 qf[3];
#pragma unroll
    for (int ks = 0; ks < 3; ++ks) qf[ks] = *(const bf16x8*)(U + (size_t)(qrow0 + fr) * NU + U_Q + h * 96 + ks * 32 + fq * 8);
    const int nkt = is_lat ? 68 : 4;
    const int kid1 = tid + 512; const bool khas1 = kid1 < 768;
    auto ksrc = [&](int id, int kt) -> const bf16_t* {
        const int key = id / 12, pc = id % 12;
        const int mrow = (kt < 4) ? (ML + b * TC + kt * 64 + key) : (b * T + (kt - 4) * 64 + key);
        return pc < 8 ? U + (size_t)mrow * NU + U_KN + h * 64 + pc * 8 : U + (size_t)mrow * NU + U_MLA + 320 + (pc - 8) * 8;
    };
    auto kdst = [&](int id, int nb) -> bf16_t* { const int key = id / 12, pc = id % 12; return Kb + nb * 6656 + key * 104 + pc * 8; };
    const int vdv = tid >> 3, vpc = tid & 7;
    u32x4 rk0 = *(const u32x4*)ksrc(tid, 0), rk1 = (u32x4){0u, 0u, 0u, 0u};
    if (khas1) rk1 = *(const u32x4*)ksrc(kid1, 0);
    u32x4 rv = *(const u32x4*)(VT + (size_t)vdv * NKEY + vpc * 8);
    __syncthreads();
    *(u32x4*)kdst(tid, 0) = rk0; if (khas1) *(u32x4*)kdst(kid1, 0) = rk1; *(u32x4*)(Vb + vdv * 72 + vpc * 8) = rv;
    __syncthreads();
    f32x4 o[4];
#pragma unroll
    for (int dt = 0; dt < 4; ++dt) o[dt] = (f32x4){0.f, 0.f, 0.f, 0.f};
    float mrun = -1e30f, lrun = 0.f;
    for (int kt = 0; kt < nkt; ++kt) {
        const int cur = kt & 1;
        if (kt + 1 < nkt) { rk0 = *(const u32x4*)ksrc(tid, kt + 1); if (khas1) rk1 = *(const u32x4*)ksrc(kid1, kt + 1); rv = *(const u32x4*)(VT + (size_t)vdv * NKEY + (kt + 1) * 64 + vpc * 8); }
        const bf16_t* Kc = Kb + cur * 6656; const bf16_t* Vc = Vb + cur * 4608;
        f32x4 s[4];
#pragma unroll
        for (int t4 = 0; t4 < 4; ++t4) { f32x4 acc = {0.f, 0.f, 0.f, 0.f};
#pragma unroll
            for (int ks = 0; ks < 3; ++ks) { const bf16x8 ka = *(const bf16x8*)(Kc + (t4 * 16 + fr) * 104 + ks * 32 + fq * 8); acc = __builtin_amdgcn_mfma_f32_16x16x32_bf16(ka, qf[ks], acc, 0, 0, 0); }
            s[t4] = acc; }
        float mx = -1e30f;
#pragma unroll
        for (int t4 = 0; t4 < 4; ++t4)
#pragma unroll
            for (int j = 0; j < 4; ++j) mx = fmaxf(mx, s[t4][j]);
        mx = fmaxf(mx, __shfl_xor(mx, 16)); mx = fmaxf(mx, __shfl_xor(mx, 32));
        const float mnew = fmaxf(mrun, mx); const float alpha = exp2f(mrun - mnew); mrun = mnew;
        float ls = 0.f;
#pragma unroll
        for (int t4 = 0; t4 < 4; ++t4)
#pragma unroll
            for (int j = 0; j < 4; ++j) { const float pv = exp2f(s[t4][j] - mnew); s[t4][j] = pv; ls += pv; }
        ls += __shfl_xor(ls, 16); ls += __shfl_xor(ls, 32);
        lrun = lrun * alpha + ls;
#pragma unroll
        for (int dt = 0; dt < 4; ++dt) o[dt] = o[dt] * alpha;
#pragma unroll
        for (int ks2 = 0; ks2 < 2; ++ks2) {
            union { bf16x8 v; unsigned w[4]; } pb;
            pb.w[0] = pk2(s[2 * ks2][0], s[2 * ks2][1]); pb.w[1] = pk2(s[2 * ks2][2], s[2 * ks2][3]); pb.w[2] = pk2(s[2 * ks2 + 1][0], s[2 * ks2 + 1][1]); pb.w[3] = pk2(s[2 * ks2 + 1][2], s[2 * ks2 + 1][3]);
#pragma unroll
            for (int dt = 0; dt < 4; ++dt) {
                union { bf16x8 v; u32x2 w[2]; } va;
                va.w[0] = *(const u32x2*)(Vc + (dt * 16 + fr) * 72 + (2 * ks2) * 16 + fq * 4);
                va.w[1] = *(const u32x2*)(Vc + (dt * 16 + fr) * 72 + (2 * ks2 + 1) * 16 + fq * 4);
                o[dt] = __builtin_amdgcn_mfma_f32_16x16x32_bf16(va.v, pb.v, o[dt], 0, 0, 0);
            }
        }
        if (kt + 1 < nkt) { *(u32x4*)kdst(tid, cur ^ 1) = rk0; if (khas1) *(u32x4*)kdst(kid1, cur ^ 1) = rk1; *(u32x4*)(Vb + (cur ^ 1) * 4608 + vdv * 72 + vpc * 8) = rv; }
        __syncthreads();
    }
    const float inv = 1.0f / lrun;
    bf16_t* AO = (bf16_t*)(a->ws + WS_AO) + (size_t)(qrow0 + fr) * 256 + h * 64;
#pragma unroll
    for (int dt = 0; dt < 4; ++dt) { u32x2 w; w.x = pk2(o[dt][0] * inv, o[dt][1] * inv); w.y = pk2(o[dt][2] * inv, o[dt][3] * inv); *(u32x2*)(AO + dt * 16 + fq * 4) = w; }
}

__device__ __forceinline__ void mlstm_a3(ArgsP a, int l, int item, unsigned char* lds) {
    LAUNDER(a);
    bf16_t* Qs = (bf16_t*)lds;
    bf16_t* Ks = (bf16_t*)(lds + 18432);
    bf16_t* VTs = (bf16_t*)(lds + 36864);
    bf16_t* Ps = (bf16_t*)(lds + 54272);
    bf16_t* CTs = (bf16_t*)(lds + 89088);
    float* OUT = (float*)(lds + 98304);
    float* sm = (float*)(lds + 131072);
    float* s_n0 = sm; float* s_li = sm + 64; float* s_lf = sm + 192; float* s_bc = sm + 320; float* s_a = sm + 448; float* s_pm = sm + 576; float* s_sp = sm + 704; float* s_em = sm + 832; float* s_dn = sm + 960;
    const int tid = otid(), lane = tid & 63, wave = tid >> 6, fr = lane & 15, fq = lane >> 4;
    const int bh = item / 34, c34 = item % 34, b = bh >> 2, h = bh & 3;
    const int tile = c34 < 2 ? 128 + b * 2 + c34 : b * 32 + (c34 - 2);
    const int m0 = tile * 128;
    const bf16_t* U = (const bf16_t*)(a->ws + WS_A);
#pragma unroll 1
    for (int dir = 0; dir < 2; ++dir) {
        const int p = tile_pos(tile, dir);
        const size_t sitem = (size_t)(bh * 2 + dir) * 34 + p;
        const float* gb = a->in[7] + l * 16 + dir * 8;
        const float m0v = ((const float*)(a->ws + WS_SC))[sitem * 4 + 2];
        if (tid < 128) { const int tok = dir ? 127 - tid : tid; const size_t m = (size_t)(m0 + tok);
            const float xi = bf2f(U[m * NU + 1024 + dir * 8 + h]) + gb[h]; const float xf = bf2f(U[m * NU + 1024 + dir * 8 + 4 + h]) + gb[4 + h];
            s_li[tid] = xi; s_lf[tid] = -softplusf_(-xf); }
        __syncthreads();
        if (tid < 128) { float bc = 0.f; for (int s = 0; s <= tid; ++s) bc += s_lf[s]; s_bc[tid] = bc; s_a[tid] = s_li[tid] - bc; }
        __syncthreads();
        if (tid < 128) { float pm = m0v; for (int s = 0; s <= tid; ++s) pm = fmaxf(pm, s_a[s]); s_pm[tid] = pm; s_sp[tid] = __expf(m0v - pm); s_em[tid] = __expf(-(s_bc[tid] + pm)); }
#pragma unroll 1
        for (int idx = tid; idx < 128 * 8; idx += 512) { const int i = idx >> 3, pc = idx & 7; const int tok = dir ? 127 - i : i; const size_t m = (size_t)(m0 + tok);
            *(u32x4*)(Qs + i * 72 + pc * 8) = *(const u32x4*)(U + m * NU + h * 64 + pc * 8);
            *(u32x4*)(Ks + i * 72 + pc * 8) = *(const u32x4*)(U + m * NU + 256 + h * 64 + pc * 8); }
#pragma unroll 2
        for (int idx = tid; idx < 128 * 64; idx += 512) { const int i = idx >> 6, d = idx & 63; const int tok = dir ? 127 - i : i; VTs[d * 136 + i] = U[(size_t)(m0 + tok) * NU + 512 + h * 64 + d]; }
        { const int dv = tid >> 3, pc = tid & 7; *(u32x4*)(CTs + dv * 72 + pc * 8) = *(const u32x4*)((const bf16_t*)(a->ws + WS_CL) + sitem * 4096 + dv * 64 + pc * 8); }
        if (tid < 64) s_n0[tid] = ((const float*)(a->ws + WS_NL))[sitem * 64 + tid];
        __syncthreads();
#pragma unroll 1
        for (int ct = 0; ct < 8; ++ct) {
            if (ct > wave) {
#pragma unroll
                for (int j = 0; j < 4; ++j) Ps[(wave * 16 + fq * 4 + j) * 136 + ct * 16 + fr] = 0;
            } else {
                const f32x4 acc = mma16(Qs, 72, wave * 16, Ks, 72, ct * 16, 64, lane);
                const int s = ct * 16 + fr; const float as = s_a[s];
#pragma unroll
                for (int j = 0; j < 4; ++j) { const int i = wave * 16 + fq * 4 + j; const float val = (s <= i) ? acc[j] * 0.125f * __expf(as - s_pm[i]) : 0.f; Ps[i * 136 + s] = (bf16_t)f2bf(val); }
            }
        }
        __syncthreads();
        if (tid < 128) { float rs = 0.f;
#pragma unroll 2
            for (int s8 = 0; s8 < 16; ++s8) { const u32x4 w = *(const u32x4*)(Ps + tid * 136 + s8 * 8);
                rs += (__uint_as_float(w.x << 16) + __uint_as_float(w.x & 0xffff0000u)) + (__uint_as_float(w.y << 16) + __uint_as_float(w.y & 0xffff0000u))
                    + (__uint_as_float(w.z << 16) + __uint_as_float(w.z & 0xffff0000u)) + (__uint_as_float(w.w << 16) + __uint_as_float(w.w & 0xffff0000u)); }
            float qn = 0.f;
#pragma unroll 2
            for (int d8 = 0; d8 < 8; ++d8) { const u32x4 w = *(const u32x4*)(Qs + tid * 72 + d8 * 8); const float* nn = s_n0 + d8 * 8;
                qn += __uint_as_float(w.x << 16) * nn[0] + __uint_as_float(w.x & 0xffff0000u) * nn[1] + __uint_as_float(w.y << 16) * nn[2] + __uint_as_float(w.y & 0xffff0000u) * nn[3]
                    + __uint_as_float(w.z << 16) * nn[4] + __uint_as_float(w.z & 0xffff0000u) * nn[5] + __uint_as_float(w.w << 16) * nn[6] + __uint_as_float(w.w & 0xffff0000u) * nn[7]; }
            const float den = rs + s_sp[tid] * qn; s_dn[tid] = 1.0f / fmaxf(fabsf(den), s_em[tid]); }
        f32x4 numr[4];
#pragma unroll
        for (int dt = 0; dt < 4; ++dt) {
            const f32x4 a1 = mma16(Ps, 136, wave * 16, VTs, 136, dt * 16, 128, lane);
            const f32x4 a2 = mma16(Qs, 72, wave * 16, CTs, 72, dt * 16, 64, lane);
#pragma unroll
            for (int j = 0; j < 4; ++j) numr[dt][j] = a1[j] + s_sp[wave * 16 + fq * 4 + j] * a2[j];
            asm volatile("" ::: "memory");
        }
        __syncthreads();
#pragma unroll
        for (int dt = 0; dt < 4; ++dt)
#pragma unroll
            for (int j = 0; j < 4; ++j) { const int i = wave * 16 + fq * 4 + j; const int tok = dir ? 127 - i : i; const float hv = numr[dt][j] * s_dn[i];
                float* op = OUT + tok * 64 + dt * 16 + fr; if (dir == 0) *op = hv; else *op += hv; }
        __syncthreads();
    }
    bf16_t* OC = (bf16_t*)(a->ws + WS_OC);
    const float ng = a->in[8][l * 256 + h * 64 + lane];
#pragma unroll 2
    for (int q = 0; q < 16; ++q) { const int tok = wave * 16 + q; const float x = OUT[tok * 64 + lane];
        const float mean = wave_sum(x) * (1.f / 64.f); const float dx = x - mean; const float var = wave_sum(dx * dx) * (1.f / 64.f);
        const float ov = bf2f(U[(size_t)(m0 + tok) * NU + 768 + h * 64 + lane]);
        const float y = dx * (1.0f / sqrtf(var + 1e-5f)) * ng * sigmoidf_(ov);
        OC[(size_t)(m0 + tok) * 1024 + h * 64 + lane] = (bf16_t)f2bf(y); }
    __syncthreads();
}

__device__ __forceinline__ void rwkv_finish_rows(ArgsP a, int l, int mrows) {
    LAUNDER(a);
    const int lane = otid() & 63, wave = otid() >> 6;
    const int gw = obid() * 8 + wave, NGW = gridDim.x * 8;
    const bf16_t* YR = (const bf16_t*)(a->ws + WS_YR); const bf16_t* RKV = (const bf16_t*)(a->ws + WS_RKV); const bf16_t* GRW = (const bf16_t*)(a->ws + WS_GRW); const float* BON = (const float*)(a->ws + WS_BON);
    const bf16_t* AO = (const bf16_t*)(a->ws + WS_AO); bf16_t* OC = (bf16_t*)(a->ws + WS_OC);
    for (int m = gw; m < mrows; m += NGW) {
#pragma unroll
        for (int k = 0; k < 4; ++k) { const int c = k * 64 + lane;
            const float y = bf2f(YR[(size_t)m * 512 + c]) + bf2f(YR[(size_t)m * 512 + 256 + c]);
            const float mean = wave_sum(y) * (1.f / 64.f); const float dy = y - mean; const float var = wave_sum(dy * dy) * (1.f / 64.f);
            const float yn = dy * (1.0f / sqrtf(var + 64e-5f)) * a->in[18][l * 256 + c];
            const float o = (yn + BON[(size_t)m * 4 + k] * bf2f(RKV[(size_t)m * 256 + c])) * bf2f(GRW[(size_t)m * 256 + c]);
            OC[(size_t)m * 1024 + 256 + c] = (bf16_t)f2bf(o);
            OC[(size_t)m * 1024 + 512 + c] = AO[(size_t)m * 256 + c]; }
    }
}

__device__ __forceinline__ void layer_body(ArgsP a, const int l, unsigned char* lds) {
    LAUNDER(a);
    cg::grid_group grid = cg::this_grid();
    const int tid = otid();
    const int G = gridDim.x, bx = obid();
    unsigned char* ws = a->ws;
    const float* mod = (const float*)(ws + WS_MOD);
    unsigned* ctl = (unsigned*)(ws + WS_CTL);
    volatile int* s_unit_p = (volatile int*)(lds + LDS_BYTES - 16);
        const bool need_ctx = l < NLAY - 1;
        const int nMr = need_ctx ? 68 : 64;
        const int mrows = need_ctx ? M : ML;
        { pg8::EpiB<0> E{(bf16_t*)(ws + WS_A), NU}; run_gemm(lds, (const bf16_t*)(ws + WS_H), 1024, 0, (const bf16_t*)(ws + WS_WU), 1024, 1024, 0x7fffffff, 68, 14, E); }
        grid.sync();
#ifndef SKIP_MIX
        for (int it = bx; it < M / 16; it += G) rwkv_prep_tile(a, l, it, lds);
        for (int it = bx; it < M / 64; it += G) mla_prep_tile(a, it, lds);
        for (int it = bx; it < 1088; it += G) mlstm_a1(a, l, it, lds);
        for (int it = bx; it < 544; it += G) lru_summary(a, l, it, lds);
        grid.sync();
        if (bx < 64) rwkv_scan(a, bx, lds);
        else if (bx < 96) mlstm_a2(a, bx - 64);
        {
            const int nunits = need_ctx ? 544 : 512;
            for (;;) {
                __syncthreads();
                if (tid == 0) *s_unit_p = (int)atomicAdd(ctl + l, 1u);
                __syncthreads();
                const int u = *s_unit_p;
                if (u >= nunits) break;
                attn_unit(a, u, lds);
            }
        }
        grid.sync();
        for (int it = bx; it < 16 * 34; it += G) { if (!need_ctx && (it % 34) < 2) continue; mlstm_a3(a, l, it, lds); }
        for (int it = bx; it < (need_ctx ? 544 : 512); it += G) { lru_output(a, l, it, lds); __syncthreads(); }
        rwkv_finish_rows(a, l, mrows);
        grid.sync();
#endif
        { pg8::EpiB<0> E{(bf16_t*)(ws + WS_A), 4096}; run_gemm(lds, (const bf16_t*)(ws + WS_OC), 1024, 256, (const bf16_t*)(ws + WS_WBR), 256, 256, 0x7fffffff, nMr, 16, E); }
        grid.sync();
        { pg8::EpiB<2> E{(bf16_t*)(ws + WS_A), 4096}; run_gemm(lds, (const bf16_t*)(ws + WS_H), 1024, 0, (const bf16_t*)(ws + WS_WG), 1024, 1024, 0x7fffffff, nMr, 16, E); }
        grid.sync();
        { pg8::EpiRes E{(float*)(ws + WS_XB), mod + (size_t)l * 5 * 6144 + 2 * 1024}; run_gemm(lds, (const bf16_t*)(ws + WS_A), 4096, 0, (const bf16_t*)(ws + WS_WO), 1024, 4096, 15, nMr, 4, E); }
        grid.sync();
        ln_phase(a, 1, a->in[33] + l * D, a->in[34] + l * D, l, 3, mrows, false);
        grid.sync();
        { pg8::EpiB<1> E{(bf16_t*)(ws + WS_A), 4096}; run_gemm(lds, (const bf16_t*)(ws + WS_H), 1024, 0, (const bf16_t*)(ws + WS_W1), 1024, 1024, 0x7fffffff, nMr, 16, E); }
        grid.sync();
        { pg8::EpiRes E{(float*)(ws + WS_XB), mod + (size_t)l * 5 * 6144 + 5 * 1024}; run_gemm(lds, (const bf16_t*)(ws + WS_A), 4096, 0, (const bf16_t*)(ws + WS_W2), 4096, 4096, 0x7fffffff, nMr, 4, E); }
        grid.sync();
        if (need_ctx) { ln_phase(a, 1, a->in[37] + l * D, a->in[38] + l * D, l + 1, 0, M, false); __syncthreads(); convert_layer(a, l + 1, lds); grid.sync(); }
        else ln_phase(a, 1, a->in[37] + l * D, a->in[38] + l * D, 0, 0, ML, true);
}

__global__ void __launch_bounds__(512, 2) fwd_megakernel(Args a_) {
    extern __shared__ __attribute__((aligned(16))) unsigned char lds[];
    volatile int* s_unit_p = (volatile int*)(lds + LDS_BYTES - 16);
    cg::grid_group grid = cg::this_grid();
    ArgsP a = (ArgsP)__builtin_amdgcn_kernarg_segment_ptr();
    const int tid = otid();
    const int G = gridDim.x, bx = obid();
    unsigned char* ws = a->ws;
    const float* mod = (const float*)(ws + WS_MOD);
    unsigned* ctl = (unsigned*)(ws + WS_CTL);

    mod_partials(a, lds);
    __syncthreads();
    convert_layer(a, 0, lds);
    grid.sync();
    mod_finalize(a);
    grid.sync();
    ln_phase(a, 0, nullptr, nullptr, 0, 0, M, false);
    grid.sync();

    layer_body(a, 0, lds);
    layer_body(a, 1, lds);
    layer_body(a, 2, lds);
    layer_body(a, 3, lds);
}

extern "C" void kernel_launch(void* const* d_in, const int* in_sizes, int n_in, void* d_out, int out_size, void* d_ws, size_t ws_size, hipStream_t stream) {
    static int grid = 0;
    if (grid == 0) {
        if (n_in != 39 || ws_size < WS_END) { fprintf(stderr, "kernel_launch: unexpected n_in %d / ws_size %zu (need %zu)\n", n_in, ws_size, (size_t)WS_END); grid = -1; return; }
        int dev = 0, cus = 0, per_cu = 0;
        hipGetDevice(&dev); hipDeviceGetAttribute(&cus, hipDeviceAttributeMultiprocessorCount, dev);
        hipFuncSetAttribute((const void*)fwd_megakernel, hipFuncAttributeMaxDynamicSharedMemorySize, LDS_BYTES);
        hipOccupancyMaxActiveBlocksPerMultiprocessor(&per_cu, (const void*)fwd_megakernel, 512, LDS_BYTES);
        (void)hipGetLastError();
        if (per_cu < 1) per_cu = 1;
        grid = cus;
    }
    if (grid < 0) return;
    hipMemsetAsync((char*)d_ws + WS_CTL, 0, 4096, stream);
    Args a{};
    for (int i = 0; i < 39; ++i) a.in[i] = (const float*)d_in[i];
    a.out = (float*)d_out; a.ws = (unsigned char*)d_ws;
    void* args[] = {&a};
    hipError_t e = hipLaunchCooperativeKernel((const void*)fwd_megakernel, dim3(grid), dim3(512), args, LDS_BYTES, stream);
    if (e != hipSuccess) fprintf(stderr, "cooperative launch failed: %s (grid %d)\n", hipGetErrorString(e), grid);
}
```
